# Optimizing an MI355X kernel written in HIP

```python
import math
import jax, jax.numpy as jnp
from jax import lax
import numpy as np

D_MODEL = 1024
BATCH = 8
SEQ = 4096
DEPTH = 2

N_MIXERS = 2
HEAD_DIM = 64
DIFF_HEADS = D_MODEL // (2 * HEAD_DIM)
DIFF_V_DIM = 2 * HEAD_DIM
DIFF_LAMBDA_STD = 0.1
MOBA_HEADS = D_MODEL // HEAD_DIM
MOBA_BLOCK = 256
MOBA_TOPK = 3
MOBA_Q_CHUNK = 32
Q_BLOCK = 128
REL_BUCKETS = 32
REL_MAX_DIST = 128
N_BIAS_COLS = MOBA_HEADS
D_FF = int(math.ceil(8 * D_MODEL / 3 / 256)) * 256
FFN_RESIDUAL = 0.5
RMS_EPS = 1e-6
SUBLN_EPS = 1e-5

kernel_name = "hybrid_diffattn_moba_macaron"


def rms_norm(x, g, eps=RMS_EPS):
    xf = x.astype(jnp.float32)
    y = xf * lax.rsqrt(jnp.mean(xf * xf, axis=-1, keepdims=True) + eps)
    return (y * g.astype(jnp.float32)).astype(x.dtype)


def swiglu(h, w_in, w_out):
    g, u = jnp.split(h @ w_in, 2, axis=-1)
    return (jax.nn.silu(g) * u) @ w_out


def rel_bucket(dist):
    n = jnp.maximum(dist, 0)
    max_exact = REL_BUCKETS // 2
    nf = jnp.maximum(n, 1).astype(jnp.float32)
    large = max_exact + (jnp.log(nf / max_exact) / math.log(REL_MAX_DIST / max_exact)
                         * (REL_BUCKETS - max_exact)).astype(jnp.int32)
    large = jnp.minimum(large, REL_BUCKETS - 1)
    return jnp.where(n < max_exact, n, large)


def diff_attention(h, w_qkv, lam_params, subln_g, w_o, rel_bias, layer_idx):
    B, S, _ = h.shape
    H, d = DIFF_HEADS, HEAD_DIM
    q, k, v = jnp.split(h @ w_qkv, 3, axis=-1)
    q = q.reshape(B, S, 2 * H, d).transpose(0, 2, 1, 3)
    k = k.reshape(B, S, 2 * H, d).transpose(0, 2, 1, 3)
    v = v.reshape(B, S, H, DIFF_V_DIM).transpose(0, 2, 1, 3)
    lp = lam_params.astype(jnp.float32)
    lam_init = 0.8 - 0.6 * math.exp(-0.3 * layer_idx)
    lam = jnp.exp(jnp.sum(lp[0] * lp[1])) - jnp.exp(jnp.sum(lp[2] * lp[3])) + lam_init
    n_qb = S // Q_BLOCK
    q_blocks = q.reshape(B, 2 * H, n_qb, Q_BLOCK, d).transpose(2, 0, 1, 3, 4)
    k_pos = jnp.arange(S)
    scale = d ** -0.5

    def block(args):
        qb_idx, qb = args
        q_pos = qb_idx * Q_BLOCK + jnp.arange(Q_BLOCK)
        dist = q_pos[:, None] - k_pos[None, :]
        bias = jnp.moveaxis(rel_bias[rel_bucket(dist)], -1, 0).astype(jnp.float32)
        s = jnp.einsum('bmqd,bmkd->bmqk', qb, k).astype(jnp.float32) * scale + bias
        s = jnp.where(dist >= 0, s, -jnp.inf)
        p = jax.nn.softmax(s, axis=-1).reshape(B, H, 2, Q_BLOCK, S)
        a = p[:, :, 0] - lam * p[:, :, 1]
        return jnp.einsum('bhqk,bhkv->bhqv', a.astype(v.dtype), v)

    o = lax.map(block, (jnp.arange(n_qb), q_blocks))
    o = o.transpose(1, 2, 0, 3, 4).reshape(B, H, S, DIFF_V_DIM)
    o = rms_norm(o, subln_g, SUBLN_EPS) * (1.0 - lam_init)
    o = o.transpose(0, 2, 1, 3).reshape(B, S, H * DIFF_V_DIM)
    return o @ w_o


def moba_attention(h, w_qkv, w_o, rel_bias):
    B, S, _ = h.shape
    H, d, L, C = MOBA_HEADS, HEAD_DIM, MOBA_BLOCK, MOBA_Q_CHUNK
    q, k, v = jnp.split(h @ w_qkv, 3, axis=-1)
    q = q.reshape(B, S, H, d).transpose(0, 2, 1, 3)
    k = k.reshape(B, S, H, d).transpose(0, 2, 1, 3)
    v = v.reshape(B, S, H, d).transpose(0, 2, 1, 3)
    n_blk = -(-S // L)
    S_pad = n_blk * L
    pad = ((0, 0), (0, 0), (0, S_pad - S), (0, 0))
    q, k, v = jnp.pad(q, pad), jnp.pad(k, pad), jnp.pad(v, pad)
    kb = k.reshape(B, H, n_blk, L, d)
    vb = v.reshape(B, H, n_blk, L, d)
    k_mean = jnp.mean(kb.astype(jnp.float32), axis=3)
    gate = jnp.einsum('bhsd,bhnd->bhsn', q.astype(jnp.float32), k_mean)
    q_blk = jnp.arange(S_pad) // L
    eligible = jnp.arange(n_blk)[None, :] < q_blk[:, None]
    gate = jnp.where(eligible, gate, -jnp.inf)
    n_sel = min(MOBA_TOPK, n_blk)
    _, sel = lax.top_k(gate, n_sel)
    valid = sel < q_blk[:, None]
    n_ch = S_pad // C

    def to_chunks(a):
        return a.reshape(B, H, n_ch, C, a.shape[-1]).transpose(2, 0, 1, 3, 4)

    b_idx = jnp.arange(B)[:, None, None, None]
    h_idx = jnp.arange(H)[None, :, None, None]
    bias_t = rel_bias.T.astype(jnp.float32)
    scale = d ** -0.5

    def chunk(args):
        c, qc, selc, validc = args
        q_pos = c * C + jnp.arange(C)
        own = (c * C) // L
        kg = kb[b_idx, h_idx, selc]
        vg = vb[b_idx, h_idx, selc]
        kpos_past = selc[..., None] * L + jnp.arange(L)
        bias_past = bias_t[h_idx[..., None], rel_bucket(q_pos[:, None, None] - kpos_past)]
        s_past = jnp.einsum('bhqd,bhqnld->bhqnl', qc, kg).astype(jnp.float32) * scale + bias_past
        s_past = jnp.where(validc[..., None], s_past, -jnp.inf)
        ko = lax.dynamic_index_in_dim(kb, own, axis=2, keepdims=False)
        vo = lax.dynamic_index_in_dim(vb, own, axis=2, keepdims=False)
        dist_own = q_pos[:, None] - (own * L + jnp.arange(L))[None, :]
        bias_own = jnp.moveaxis(bias_t.T[rel_bucket(dist_own)], -1, 0)
        s_own = jnp.einsum('bhqd,bhld->bhql', qc, ko).astype(jnp.float32) * scale + bias_own
        s_own = jnp.where(dist_own >= 0, s_own, -jnp.inf)
        s = jnp.concatenate([s_past.reshape(B, H, C, n_sel * L), s_own], axis=-1)
        p = jax.nn.softmax(s, axis=-1).astype(v.dtype)
        p_past = p[..., :n_sel * L].reshape(B, H, C, n_sel, L)
        p_own = p[..., n_sel * L:]
        return (jnp.einsum('bhqnl,bhqnld->bhqd', p_past, vg)
                + jnp.einsum('bhql,bhld->bhqd', p_own, vo))

    o = lax.map(chunk, (jnp.arange(n_ch), to_chunks(q), to_chunks(sel), to_chunks(valid)))
    o = o.transpose(1, 0, 3, 2, 4).reshape(B, S_pad, H * d)[:, :S]
    return o @ w_o


def setup_inputs(seed: int = 0) -> dict:
    key = jax.random.key(seed)
    ks = jax.random.split(key, 12)
    D, F = D_MODEL, D_FF
    n_a = len(range(0, DEPTH, N_MIXERS))
    n_b = len(range(1, DEPTH, N_MIXERS))
    nrm = jax.random.normal
    f32 = jnp.float32
    return {
        'x': nrm(ks[0], (BATCH, SEQ, D), f32),
        'rel_bias': 0.2 * nrm(ks[1], (REL_BUCKETS, N_BIAS_COLS), f32),
        'norm_g': 1.0 + 0.02 * nrm(ks[2], (DEPTH, 3, D), f32),
        'final_norm_g': 1.0 + 0.02 * nrm(ks[3], (D,), f32),
        'ffn_w_in': nrm(ks[4], (DEPTH, 2, D, 2 * F), f32) * D ** -0.5,
        'ffn_w_out': nrm(ks[5], (DEPTH, 2, F, D), f32) * F ** -0.5,
        'diff_w_qkv': nrm(ks[6], (n_a, D, 3 * DIFF_HEADS * DIFF_V_DIM), f32) * D ** -0.5,
        'diff_lambda': DIFF_LAMBDA_STD * nrm(ks[7], (n_a, 4, HEAD_DIM), f32),
        'diff_subln_g': 1.0 + 0.02 * nrm(ks[8], (n_a, DIFF_V_DIM), f32),
        'diff_w_o': nrm(ks[9], (n_a, DIFF_HEADS * DIFF_V_DIM, D), f32) * (DIFF_HEADS * DIFF_V_DIM) ** -0.5,
        'moba_w_qkv': nrm(ks[10], (n_b, D, 3 * MOBA_HEADS * HEAD_DIM), f32) * D ** -0.5,
        'moba_w_o': nrm(ks[11], (n_b, MOBA_HEADS * HEAD_DIM, D), f32) * (MOBA_HEADS * HEAD_DIM) ** -0.5,
    }


def reference(x, rel_bias, norm_g, final_norm_g, ffn_w_in, ffn_w_out, diff_w_qkv, diff_lambda,
              diff_subln_g, diff_w_o, moba_w_qkv, moba_w_o):
    h = x
    for i in range(DEPTH):
        g = norm_g[i]
        h = h + FFN_RESIDUAL * swiglu(rms_norm(h, g[0]), ffn_w_in[i, 0], ffn_w_out[i, 0])
        hn = rms_norm(h, g[1])
        j = i // N_MIXERS
        if i % N_MIXERS == 0:
            mix = diff_attention(hn, diff_w_qkv[j], diff_lambda[j], diff_subln_g[j], diff_w_o[j], rel_bias, i)
        else:
            mix = moba_attention(hn, moba_w_qkv[j], moba_w_o[j], rel_bias)
        h = h + mix
        h = h + FFN_RESIDUAL * swiglu(rms_norm(h, g[2]), ffn_w_in[i, 1], ffn_w_out[i, 1])
    return rms_norm(h, final_norm_g)
```

```cpp
#include <hip/hip_runtime.h>
#include <hip/hip_cooperative_groups.h>
#include <cstdio>
#include <cstdint>
namespace cg = cooperative_groups;

#ifndef USE_FAST_GEMM
#define USE_FAST_GEMM 1
#endif
#ifndef SKIP_ATTN_MASK
#define SKIP_ATTN_MASK 0
#endif
#ifndef MOBA_LAG
#define MOBA_LAG 1
#endif
#ifndef DIFF_FUSED
#define DIFF_FUSED 0
#endif
#ifndef DIFF_LAG
#define DIFF_LAG 0
#endif
#ifndef GEMM_ALIGN_EPI
#define GEMM_ALIGN_EPI true
#endif
#ifndef REPEAT_ATTN
#define REPEAT_ATTN 1
#endif
#ifndef REPEAT_PRO
#define REPEAT_PRO 1
#endif
#ifndef REPEAT_SEAM
#define REPEAT_SEAM 1
#endif
#ifndef REPEAT_UP
#define REPEAT_UP 1
#endif
#ifndef MOBA_DBG_TOPK
#define MOBA_DBG_TOPK 3
#endif
#ifndef N_LAUNCH_MODE
#define N_LAUNCH_MODE 1
#endif

constexpr int BATCH = 8, SEQ = 4096, DM = 1024, MTOK = BATCH * SEQ, FF = 2816, FF2 = 2 * FF;
constexpr float LOG2E = 1.4426950408889634f;
constexpr float QSCALE = 0.125f * LOG2E;
constexpr float RMS_EPS = 1e-6f, SUBLN_EPS = 1e-5f;

namespace pg8 {
#define PG8_LAS __attribute__((address_space(3)))
typedef unsigned short bf16_t;
typedef short bf16x8 __attribute__((ext_vector_type(8)));
typedef float f32x4 __attribute__((ext_vector_type(4)));
typedef unsigned u32x4 __attribute__((ext_vector_type(4)));
constexpr int BM = 256, BK = 64, HALF = 128, HTB = HALF * BK * 2  , STAGE_BYTES = 8 * HTB, NXCD = 8, WGM = 8;

__host__ __device__ __forceinline__ int lds_byte(int r, int c) { const int st = (r >> 4) * 2 + (c >> 5), rr = r & 15, cc = c & 31, ob = rr * 64 + cc * 2; return st * 1024 + (ob ^ (((ob >> 9) & 1) << 5)); }
__host__ __device__ __forceinline__ void stage_rc(int b, int& R, int& C) { const int st = b / 1024, sb = b % 1024, swz = sb ^ (((sb >> 9) & 1) << 5); R = (st >> 1) * 16 + swz / 64; C = (st & 1) * 32 + (swz % 64) / 2; }
__host__ __device__ __forceinline__ int perm32(int rho) { const int n = rho >> 4, i = rho & 15; return 8 * (i >> 2) + 4 * n + (i & 3); }

struct Unit { int pm, pn; };
struct Gemm { const bf16_t* A; const bf16_t* Bt; int M, N, K; };

struct StaticOrder {
    int nM, nN, nwg, G, c;
    __host__ __device__ void init(int M, int N, int G_, int c_) { nM = M / BM; nN = N / BM; nwg = nM * nN; G = G_; c = c_; }
    __host__ __device__ bool next(int i, Unit& u) const {
        const long L = (long)i * G + c; if (L >= nwg) return false;
        int wgid = (int)L; { const int q = nwg / NXCD, r = nwg % NXCD, xcd = wgid % NXCD, off = wgid / NXCD; wgid = (xcd < r ? xcd * (q + 1) : r * (q + 1) + (xcd - r) * q) + off; }
        const int nig = WGM * nN, gid = wgid / nig, fm = gid * WGM, gsz = (nM - fm) < WGM ? (nM - fm) : WGM;
        u.pm = fm + ((wgid % nig) % gsz); u.pn = (wgid % nig) / gsz; return true;
    }
    __device__ __forceinline__ void a_ready(const Unit&) const {}
    __device__ __forceinline__ void done(const Unit&) const {}
};
typedef unsigned u32x2 __attribute__((ext_vector_type(2)));
typedef float cvt_f32x2 __attribute__((ext_vector_type(2))); typedef __bf16 cvt_bf16x2 __attribute__((ext_vector_type(2)));
__device__ __forceinline__ unsigned cvt_pk_bf16(float lo, float hi) { cvt_f32x2 v = {lo, hi}; cvt_bf16x2 b = __builtin_convertvector(v, cvt_bf16x2); return __builtin_bit_cast(unsigned, b); }
__device__ __forceinline__ u32x2 pack4(f32x4 v) { u32x2 w; w.x = cvt_pk_bf16(v[0], v[1]); w.y = cvt_pk_bf16(v[2], v[3]); return w; }
__device__ __forceinline__ float rstd_of(const float* ssrow) { const f32x4* q = (const f32x4*)ssrow; const f32x4 a = q[0], b = q[1], c = q[2], d = q[3];
    const float ss = ((a[0] + a[1]) + (a[2] + a[3])) + ((b[0] + b[1]) + (b[2] + b[3])) + (((c[0] + c[1]) + (c[2] + c[3])) + ((d[0] + d[1]) + (d[2] + d[3])));
    const float r = __builtin_amdgcn_rsqf(ss * (1.0f / 1024.0f) + 1e-6f); asm volatile("" ::: "memory"); return r; }

__device__ __forceinline__ float rstd_row4(const float* ssrow, int fq) { const f32x4 a = *(const f32x4*)(ssrow + 4 * fq); float ss = (a[0] + a[1]) + (a[2] + a[3]);
    ss += __shfl_xor(ss, 16); ss += __shfl_xor(ss, 32); return __builtin_amdgcn_rsqf(ss * (1.0f / 1024.0f) + 1e-6f); }
struct EpiSwiglu {
    static constexpr bool PERM = true, AFTER_DRAIN = false;
    bf16_t* out; const float* ss;
    __device__ __forceinline__ void operator()(const f32x4 (&acc)[2][2][4][2], const Unit& u, int wr, int wc, int fr, int fq) const {
#pragma unroll
        for (int ai = 0; ai < 2; ++ai)
#pragma unroll
            for (int m = 0; m < 4; ++m) {
                const int row = u.pm * BM + ai * HALF + wr * 64 + m * 16 + fr; const float rs = rstd_row4(ss + (size_t)row * 16, fq);
                bf16_t* rowp = out + (size_t)row * 2816 + u.pn * 128 + wc * 32 + fq * 8;
                u32x4 w;
#pragma unroll
                for (int n = 0; n < 2; ++n) { const f32x4 g = acc[ai][0][m][n] * rs, up = acc[ai][1][m][n] * rs;
                    const f32x4 ta = g * (-1.4426950408889634f); f32x4 t;
                    t[0] = __builtin_amdgcn_exp2f(ta[0]); t[1] = __builtin_amdgcn_exp2f(ta[1]); t[2] = __builtin_amdgcn_exp2f(ta[2]); t[3] = __builtin_amdgcn_exp2f(ta[3]);
                    const f32x4 dn = t + 1.0f; f32x4 r;
                    r[0] = __builtin_amdgcn_rcpf(dn[0]); r[1] = __builtin_amdgcn_rcpf(dn[1]); r[2] = __builtin_amdgcn_rcpf(dn[2]); r[3] = __builtin_amdgcn_rcpf(dn[3]);
                    const f32x4 h = (g * up) * r;
                    const u32x2 pk = pack4(h); if (n == 0) { w.x = pk.x; w.y = pk.y; } else { w.z = pk.x; w.w = pk.y; } }
                *(u32x4*)rowp = w;
            }
    }
};
template <bool F32IN>
struct EpiResid {
    static constexpr bool PERM = true, AFTER_DRAIN = false;
    const float* hin; bf16_t* xa; float* ssout; float alpha;
    __device__ __forceinline__ size_t goff(const Unit& u, int g, int wr, int wc, int fr, int fq) const { return (size_t)(u.pm * BM + (g >> 2) * HALF + wr * 64 + (g & 3) * 16 + fr) * 1024 + u.pn * BM + wc * 32 + fq * 8; }
    struct Grp { f32x4 f[4]; };
    __device__ __forceinline__ void gload(Grp& h, size_t off) const {
        if constexpr (F32IN) { h.f[0] = *(const f32x4*)(hin + off); h.f[1] = *(const f32x4*)(hin + off + 4); h.f[2] = *(const f32x4*)(hin + off + HALF); h.f[3] = *(const f32x4*)(hin + off + HALF + 4); }
        else { const u32x4 a = *(const u32x4*)(xa + off), b = *(const u32x4*)(xa + off + HALF); h.f[0] = __builtin_bit_cast(f32x4, a); h.f[2] = __builtin_bit_cast(f32x4, b); }
    }
    __device__ __forceinline__ void unpack(const Grp& h, int bj, f32x4& v0, f32x4& v1) const {
        if constexpr (F32IN) { v0 = h.f[2 * bj]; v1 = h.f[2 * bj + 1]; }
        else { const u32x4 w = __builtin_bit_cast(u32x4, h.f[2 * bj]);
            v0[0] = __uint_as_float(w.x << 16); v0[1] = __uint_as_float(w.x & 0xffff0000u); v0[2] = __uint_as_float(w.y << 16); v0[3] = __uint_as_float(w.y & 0xffff0000u);
            v1[0] = __uint_as_float(w.z << 16); v1[1] = __uint_as_float(w.z & 0xffff0000u); v1[2] = __uint_as_float(w.w << 16); v1[3] = __uint_as_float(w.w & 0xffff0000u); }
    }
    __device__ __forceinline__ void operator()(const f32x4 (&acc)[2][2][4][2], const Unit& u, int wr, int wc, int fr, int fq) const {
        Grp h[2];
        gload(h[0], goff(u, 0, wr, wc, fr, fq));
#pragma unroll
        for (int g = 0; g < 8; ++g) {
            const int ai = g >> 2, m = g & 3; const size_t off = goff(u, g, wr, wc, fr, fq);
            if (g < 7) gload(h[(g + 1) & 1], goff(u, g + 1, wr, wc, fr, fq));
            float sq = 0.f;
#pragma unroll
            for (int bj = 0; bj < 2; ++bj) { const size_t o = off + bj * HALF; f32x4 h0, h1; unpack(h[g & 1], bj, h0, h1);
                h0 = h0 + acc[ai][bj][m][0] * alpha; h1 = h1 + acc[ai][bj][m][1] * alpha;
                const u32x2 p0 = pack4(h0), p1 = pack4(h1); u32x4 w; w.x = p0.x; w.y = p0.y; w.z = p1.x; w.w = p1.y; *(u32x4*)(xa + o) = w;
                sq += ((h0[0] * h0[0] + h0[1] * h0[1]) + (h0[2] * h0[2] + h0[3] * h0[3])) + ((h1[0] * h1[0] + h1[1] * h1[1]) + (h1[2] * h1[2] + h1[3] * h1[3])); }
            sq += __shfl_xor(sq, 16); sq += __shfl_xor(sq, 32);
            if (fq == 0) ssout[(size_t)(u.pm * BM + ai * HALF + wr * 64 + m * 16 + fr) * 16 + u.pn * 4 + wc] = sq;
            asm volatile("" ::: "memory");
        }
    }
};
struct EpiQK {
    static constexpr bool PERM = true, AFTER_DRAIN = false;
    bf16_t* Qo; bf16_t* Ko; const float* ss; float* kmean;
    __device__ __forceinline__ void operator()(const f32x4 (&acc)[2][2][4][2], const Unit& u, int wr, int wc, int fr, int fq) const {
        const int colt = u.pn * BM; bf16_t* base = colt < 1024 ? Qo : Ko; const int cc = (colt & 1023) + wc * 32 + fq * 8;
        const bool km = (kmean != nullptr) && colt >= 1024;
        f32x4 cs[2][2];
#pragma unroll
        for (int bj = 0; bj < 2; ++bj)
#pragma unroll
            for (int n = 0; n < 2; ++n) cs[bj][n] = (f32x4){0.f, 0.f, 0.f, 0.f};
#pragma unroll
        for (int ai = 0; ai < 2; ++ai)
#pragma unroll
            for (int m = 0; m < 4; ++m) {
                const int row = u.pm * BM + ai * HALF + wr * 64 + m * 16 + fr; const float rs = rstd_row4(ss + (size_t)row * 16, fq);
                bf16_t* rowp = base + (size_t)row * 1024 + cc;
#pragma unroll
                for (int bj = 0; bj < 2; ++bj) { const f32x4 v0 = acc[ai][bj][m][0] * rs, v1 = acc[ai][bj][m][1] * rs; const u32x2 p0 = pack4(v0), p1 = pack4(v1);
                    u32x4 w; w.x = p0.x; w.y = p0.y; w.z = p1.x; w.w = p1.y; *(u32x4*)(rowp + bj * HALF) = w; cs[bj][0] = cs[bj][0] + v0; cs[bj][1] = cs[bj][1] + v1; }
            }
        if (km) {
#pragma unroll
            for (int bj = 0; bj < 2; ++bj)
#pragma unroll
                for (int n = 0; n < 2; ++n)
#pragma unroll
                    for (int i = 0; i < 4; ++i) { float v = cs[bj][n][i]; v += __shfl_xor(v, 1); v += __shfl_xor(v, 2); v += __shfl_xor(v, 4); v += __shfl_xor(v, 8);
                        if (fr == 0) kmean[(size_t)(u.pm * 2 + wr) * 1024 + cc + bj * HALF + n * 4 + i] = v; }
        }
    }
};
struct EpiVT {
    static constexpr bool PERM = false, AFTER_DRAIN = false;
    bf16_t* VT; const float* ss;
    __device__ __forceinline__ void operator()(const f32x4 (&acc)[2][2][4][2], const Unit& u, int wr, int wc, int fr, int fq) const {
#pragma unroll
        for (int bj = 0; bj < 2; ++bj)
#pragma unroll
            for (int n = 0; n < 2; ++n) {
                const int tok = u.pn * BM + bj * HALF + wc * 32 + n * 16 + fq * 4; f32x4 rs; rs[0] = rstd_of(ss + (size_t)tok * 16); rs[1] = rstd_of(ss + (size_t)tok * 16 + 16); rs[2] = rstd_of(ss + (size_t)tok * 16 + 32); rs[3] = rstd_of(ss + (size_t)tok * 16 + 48);
#pragma unroll
                for (int ai = 0; ai < 2; ++ai)
#pragma unroll
                    for (int m = 0; m < 4; ++m) { const int c = u.pm * BM + ai * HALF + wr * 64 + m * 16 + fr; *(u32x2*)(VT + (size_t)c * 32768 + tok) = pack4(acc[ai][bj][m][n] * rs); }
            }
    }
};

template <class Epi, class Sched>
__device__ __forceinline__ void gemm_simple(const Gemm g, const Sched& S, const Epi& E) {
    static_assert(!Epi::PERM, "gemm_simple stages no permuted weight rows");
    int tid_ = threadIdx.x; asm volatile("" : "+v"(tid_));
    const int tid = tid_, wid = __builtin_amdgcn_readfirstlane(tid >> 6), lane = tid & 63, wr = wid >> 2, wc = wid & 3, fr = lane & 15, fq = lane >> 4;
    const int K = g.K; Unit u;
    for (int ui = 0; S.next(ui, u); ++ui) {
        f32x4 acc[2][2][4][2];
#pragma unroll
        for (int a = 0; a < 2; ++a)
#pragma unroll
            for (int b = 0; b < 2; ++b)
#pragma unroll
                for (int m = 0; m < 4; ++m)
#pragma unroll
                    for (int n = 0; n < 2; ++n) acc[a][b][m][n] = (f32x4){0.f, 0.f, 0.f, 0.f};
        const bf16_t* Ab = g.A + (size_t)(u.pm * BM + wr * 64 + fr) * K + fq * 8;
        const bf16_t* Bb = g.Bt + (size_t)(u.pn * BM + wc * 32 + fr) * K + fq * 8;
        for (int k0 = 0; k0 < K; k0 += 32) {
            bf16x8 af[2][4], bfr[2][2];
#pragma unroll
            for (int ai = 0; ai < 2; ++ai)
#pragma unroll
                for (int m = 0; m < 4; ++m) af[ai][m] = *(const bf16x8*)(Ab + (size_t)(ai * HALF + m * 16) * K + k0);
#pragma unroll
            for (int bj = 0; bj < 2; ++bj)
#pragma unroll
                for (int n = 0; n < 2; ++n) bfr[bj][n] = *(const bf16x8*)(Bb + (size_t)(bj * HALF + n * 16) * K + k0);
#pragma unroll
            for (int ai = 0; ai < 2; ++ai)
#pragma unroll
                for (int bj = 0; bj < 2; ++bj)
#pragma unroll
                    for (int m = 0; m < 4; ++m)
#pragma unroll
                        for (int n = 0; n < 2; ++n) acc[ai][bj][m][n] = __builtin_amdgcn_mfma_f32_16x16x32_bf16(bfr[bj][n], af[ai][m], acc[ai][bj][m][n], 0, 0, 0);
        }
        E(acc, u, wr, wc, fr, fq);
    }
}

template <class Epi, class Sched, bool ALIGN_EPI = false, bool SP2 = false>
__device__ __forceinline__ void gemm_phase(PG8_LAS unsigned char* lds, const Gemm g, const Sched& S, const Epi& E) {
    int tid_ = threadIdx.x; asm volatile("" : "+v"(tid_));
    const int tid = tid_, wid = __builtin_amdgcn_readfirstlane(tid >> 6), lane = tid & 63, wr = wid >> 2, wc = wid & 3, fr = lane & 15, fq = lane >> 4;
    const int K = g.K, nt = K / BK;
    unsigned voffA[2], voffB[2];
#pragma unroll
    for (int i = 0; i < 2; ++i) { int R, C; stage_rc(tid * 16 + i * 8192, R, C); const int Rb = Epi::PERM ? ((R & ~31) + perm32(R & 31)) : R;
        voffA[i] = (unsigned)(R * K + C) * 2u; voffB[i] = (unsigned)(Rb * K + C) * 2u; }
    const size_t kstep = (size_t)(BK * 2);
    const size_t hstep = (size_t)HALF * K * 2;
    const size_t tstep = 2 * hstep;
    const unsigned ldsw = (unsigned)wid * 1024u;
    const int aoff = lds_byte(wr * 64 + fr, fq * 8), boff = lds_byte(wc * 32 + fr, fq * 8);
#define PG8_SA(b, h) (((b) * 2 + (h)) * HTB)
#define PG8_SB(b, h) ((4 + (b) * 2 + (h)) * HTB)
#define PG8_STAGE(bufoff, gbase, voff) do { _Pragma("unroll") for (int _i = 0; _i < 2; ++_i) \
        __builtin_amdgcn_global_load_lds((const unsigned*)((const char*)(gbase) + (voff)[_i]), (PG8_LAS unsigned*)(lds + (bufoff) + ldsw + _i * 8192), 16, 0, 0); } while (0)
#define PG8_LDA(dst, b, h) do { _Pragma("unroll") for (int m = 0; m < 4; ++m) _Pragma("unroll") for (int k = 0; k < 2; ++k) dst[m][k] = *(const PG8_LAS bf16x8*)(lds + PG8_SA(b, h) + aoff + m * 2048 + k * 1024); } while (0)
#define PG8_LDB(dst, b, h) do { _Pragma("unroll") for (int n = 0; n < 2; ++n) _Pragma("unroll") for (int k = 0; k < 2; ++k) dst[n][k] = *(const PG8_LAS bf16x8*)(lds + PG8_SB(b, h) + boff + n * 2048 + k * 1024); } while (0)
#define PG8_MMA(ai, bj, At, Bt) do { __builtin_amdgcn_s_setprio(1); _Pragma("unroll") for (int m = 0; m < 4; ++m) _Pragma("unroll") for (int n = 0; n < 2; ++n) _Pragma("unroll") for (int k = 0; k < 2; ++k) \
        acc[ai][bj][m][n] = __builtin_amdgcn_mfma_f32_16x16x32_bf16(Bt[n][k], At[m][k], acc[ai][bj][m][n], 0, 0, 0); __builtin_amdgcn_s_setprio(0); } while (0)
#define PG8_WAIT_V(n) asm volatile("s_waitcnt vmcnt(" #n ")" ::: "memory")
#define PG8_WAIT_L(n) asm volatile("s_waitcnt lgkmcnt(" #n ")" ::: "memory")
#define PG8_BAR __builtin_amdgcn_s_barrier()
#define PG8_SCHED __builtin_amdgcn_sched_barrier(0)
    Unit cur, nxt; int ui = 0;
    if (!S.next(0, cur)) return;
    f32x4 acc[2][2][4][2];
#pragma unroll
    for (int a = 0; a < 2; ++a)
#pragma unroll
        for (int b = 0; b < 2; ++b)
#pragma unroll
            for (int m = 0; m < 4; ++m)
#pragma unroll
                for (int n = 0; n < 2; ++n) acc[a][b][m][n] = (f32x4){0.f, 0.f, 0.f, 0.f};
    bf16x8 At[4][2], B0[2][2], B1[2][2];
    const char* cA = (const char*)g.A + (size_t)cur.pm * tstep; const char* cB = (const char*)g.Bt + (size_t)cur.pn * tstep;
    S.a_ready(cur);
    if constexpr (SP2) {
        PG8_STAGE(PG8_SB(0, 0), cB, voffB); PG8_STAGE(PG8_SB(0, 1), cB + hstep, voffB); PG8_STAGE(PG8_SA(0, 0), cA, voffA); PG8_STAGE(PG8_SA(0, 1), cA + hstep, voffA);
        if (wr == 1) PG8_BAR;
        PG8_WAIT_V(2); PG8_BAR;
        PG8_STAGE(PG8_SB(1, 0), cB + kstep, voffB); PG8_STAGE(PG8_SA(1, 0), cA + kstep, voffA); PG8_STAGE(PG8_SB(1, 1), cB + hstep + kstep, voffB);
        PG8_WAIT_V(6); PG8_BAR;
    } else {
        PG8_STAGE(PG8_SB(0, 0), cB, voffB); PG8_STAGE(PG8_SA(0, 0), cA, voffA); PG8_STAGE(PG8_SB(0, 1), cB + hstep, voffB); PG8_STAGE(PG8_SA(0, 1), cA + hstep, voffA);
        if (wr == 1) PG8_BAR;
        PG8_WAIT_V(4); PG8_BAR;
        PG8_STAGE(PG8_SB(1, 0), cB + kstep, voffB); PG8_STAGE(PG8_SA(1, 0), cA + kstep, voffA); PG8_STAGE(PG8_SB(1, 1), cB + hstep + kstep, voffB);
        PG8_WAIT_V(6); PG8_BAR;
    }
    for (;;) {
        const bool has_next = S.next(ui + 1, nxt);
        const char* nA = has_next ? (const char*)g.A + (size_t)nxt.pm * tstep : cA; const char* nB = has_next ? (const char*)g.Bt + (size_t)nxt.pn * tstep : cB;
        for (int t = 0; t < nt; t += 2) {
            const bool last = (t == nt - 2);
            const char* a1 = cA + (size_t)(t + 1) * kstep;
            const char* a2 = last ? nA : cA + (size_t)(t + 2) * kstep; const char* b2 = last ? nB : cB + (size_t)(t + 2) * kstep;
            const char* a3 = a2 + kstep; const char* b3 = b2 + kstep;
            if (last && has_next) S.a_ready(nxt);
            if constexpr (SP2) {
            PG8_LDB(B0, 0, 0); PG8_LDB(B1, 0, 1); PG8_SCHED; PG8_LDA(At, 0, 0); PG8_STAGE(PG8_SA(1, 1), a1 + hstep, voffA);
            PG8_WAIT_V(8); PG8_WAIT_L(0); PG8_BAR; PG8_MMA(0, 0, At, B0); PG8_MMA(0, 1, At, B1); PG8_BAR; PG8_SCHED;
            PG8_LDA(At, 0, 1); PG8_STAGE(PG8_SB(0, 0), b2, voffB); PG8_STAGE(PG8_SB(0, 1), b2 + hstep, voffB); PG8_STAGE(PG8_SA(0, 0), a2, voffA);
            PG8_WAIT_V(8); PG8_WAIT_L(0); PG8_BAR; PG8_MMA(1, 0, At, B0); PG8_MMA(1, 1, At, B1); PG8_BAR; PG8_SCHED;
            PG8_LDB(B0, 1, 0); PG8_LDB(B1, 1, 1); PG8_SCHED; PG8_LDA(At, 1, 0); PG8_STAGE(PG8_SA(0, 1), a2 + hstep, voffA);
            PG8_WAIT_V(8); PG8_WAIT_L(0); PG8_BAR; PG8_MMA(0, 0, At, B0); PG8_MMA(0, 1, At, B1); PG8_BAR; PG8_SCHED;
            PG8_LDA(At, 1, 1); PG8_STAGE(PG8_SB(1, 0), b3, voffB); PG8_STAGE(PG8_SB(1, 1), b3 + hstep, voffB); PG8_STAGE(PG8_SA(1, 0), a3, voffA);
            PG8_WAIT_V(8); PG8_WAIT_L(0); PG8_BAR; PG8_MMA(1, 0, At, B0); PG8_MMA(1, 1, At, B1); PG8_BAR; PG8_SCHED;
            } else {
            PG8_LDB(B0, 0, 0); PG8_SCHED; PG8_LDA(At, 0, 0); PG8_STAGE(PG8_SA(1, 1), a1 + hstep, voffA);
            PG8_WAIT_L(8); PG8_BAR; PG8_WAIT_L(0); PG8_MMA(0, 0, At, B0); PG8_BAR; PG8_SCHED;
            PG8_LDB(B1, 0, 1); PG8_STAGE(PG8_SB(0, 0), b2, voffB);
            PG8_BAR; PG8_WAIT_L(0); PG8_MMA(0, 1, At, B1); PG8_BAR;
            PG8_LDA(At, 0, 1); PG8_STAGE(PG8_SA(0, 0), a2, voffA);
            PG8_BAR; PG8_WAIT_L(0); PG8_MMA(1, 0, At, B0); PG8_BAR; PG8_SCHED;
            PG8_STAGE(PG8_SB(0, 1), b2 + hstep, voffB);
            PG8_WAIT_V(6); PG8_BAR; PG8_MMA(1, 1, At, B1); PG8_BAR;
            PG8_LDB(B0, 1, 0); PG8_SCHED; PG8_LDA(At, 1, 0); PG8_STAGE(PG8_SA(0, 1), a2 + hstep, voffA);
            PG8_WAIT_L(8); PG8_BAR; PG8_WAIT_L(0); PG8_MMA(0, 0, At, B0); PG8_BAR; PG8_SCHED;
            PG8_LDB(B1, 1, 1); PG8_STAGE(PG8_SB(1, 0), b3, voffB);
            PG8_BAR; PG8_WAIT_L(0); PG8_MMA(0, 1, At, B1); PG8_BAR;
            PG8_LDA(At, 1, 1); PG8_STAGE(PG8_SA(1, 0), a3, voffA);
            PG8_BAR; PG8_WAIT_L(0); PG8_MMA(1, 0, At, B0); PG8_BAR; PG8_SCHED;
            PG8_STAGE(PG8_SB(1, 1), b3 + hstep, voffB);
            PG8_WAIT_V(6); PG8_BAR; PG8_MMA(1, 1, At, B1); PG8_BAR;
            }
        }
        if constexpr (ALIGN_EPI) { if (wr == 0) PG8_BAR; }
        if constexpr (!Epi::AFTER_DRAIN) { E(acc, cur, wr, wc, fr, fq); S.done(cur); }
        if (!has_next) break;
#pragma unroll
        for (int a = 0; a < 2; ++a)
#pragma unroll
            for (int b = 0; b < 2; ++b)
#pragma unroll
                for (int m = 0; m < 4; ++m)
#pragma unroll
                    for (int n = 0; n < 2; ++n) acc[a][b][m][n] = (f32x4){0.f, 0.f, 0.f, 0.f};
        cur = nxt; cA = nA; cB = nB; ++ui;
        if constexpr (ALIGN_EPI) { if (wr == 1) PG8_BAR; }
    }
    PG8_WAIT_V(0);
    if constexpr (!ALIGN_EPI) { if (wr == 0) PG8_BAR; }
    PG8_BAR;
    if constexpr (Epi::AFTER_DRAIN) { E.fused(acc, cur, wr, wc, fr, fq, lds, wid, lane); S.done(cur); }
#undef PG8_SA
#undef PG8_SB
#undef PG8_STAGE
#undef PG8_LDA
#undef PG8_LDB
#undef PG8_MMA
#undef PG8_WAIT_V
#undef PG8_WAIT_L
#undef PG8_BAR
#undef PG8_SCHED
}
}
namespace att {
using pg8::bf16_t; using pg8::bf16x8; using pg8::u32x4; using pg8::u32x2;
typedef float f32x16 __attribute__((ext_vector_type(16)));
#define ALAS __attribute__((address_space(3)))
constexpr int ROWB = 144;
constexpr float NEG = -1e30f;
__device__ __forceinline__ int kperm(int i) { return (i & 19) | ((i & 4) << 1) | ((i & 8) >> 1); }
__device__ __forceinline__ int crow(int r, int hi) { return (r & 3) + 8 * (r >> 2) + 4 * hi; }
__device__ __forceinline__ unsigned cvtpk(float lo, float hi) { return pg8::cvt_pk_bf16(lo, hi); }
__device__ __forceinline__ float ex2(float x) { return __builtin_amdgcn_exp2f(x); }

template <int OFF> __device__ __forceinline__ void ldsr(bf16x8& d, unsigned a) { asm volatile("ds_read_b128 %0, %1 offset:%c2" : "=v"(d) : "v"(a), "i"(OFF) : "memory"); }
__device__ __forceinline__ void lds_wait8(bf16x8 (&a)[8]) { asm volatile("s_waitcnt lgkmcnt(0)" : "+v"(a[0]), "+v"(a[1]), "+v"(a[2]), "+v"(a[3]), "+v"(a[4]), "+v"(a[5]), "+v"(a[6]), "+v"(a[7]) :: "memory"); }
__device__ __forceinline__ void lds_wait4(bf16x8 (&a)[4]) { asm volatile("s_waitcnt lgkmcnt(0)" : "+v"(a[0]), "+v"(a[1]), "+v"(a[2]), "+v"(a[3]) :: "memory"); }
__device__ __forceinline__ void glds16(const void* gsrc, unsigned lds_dst) { unsigned keep;
    asm volatile("s_mov_b32 %0, m0\n\ts_mov_b32 m0, %2\n\ts_nop 0\n\tglobal_load_lds_dwordx4 %1, off\n\ts_mov_b32 m0, %0" : "=&s"(keep) : "v"(gsrc), "s"(lds_dst) : "memory"); }
__device__ __forceinline__ int swz_src_chunk(int row, int lane) { return (lane & 7) ^ ((row >> 1) & 7); }
__device__ __forceinline__ void qk_tile(f32x16& s0, f32x16& s1, float ci, unsigned kimg, const unsigned (&ko)[4], const bf16x8 (&qf)[4]) {
    bf16x8 a[8];
#pragma unroll
    for (int d0 = 0; d0 < 4; ++d0) { const unsigned ad = kimg + ko[d0]; ldsr<0>(a[2 * d0], ad); ldsr<4096>(a[2 * d0 + 1], ad); }
#pragma unroll
    for (int r = 0; r < 16; ++r) { s0[r] = ci; s1[r] = ci; }
    lds_wait8(a); __builtin_amdgcn_sched_barrier(0);
#pragma unroll
    for (int d0 = 0; d0 < 4; ++d0) {
        s0 = __builtin_amdgcn_mfma_f32_32x32x16_bf16(a[2 * d0], qf[d0], s0, 0, 0, 0);
        s1 = __builtin_amdgcn_mfma_f32_32x32x16_bf16(a[2 * d0 + 1], qf[d0], s1, 0, 0, 0);
    }
}
template <int NDB, int KB>
__device__ __forceinline__ void issue_v(bf16x8 (&v)[2 * NDB], unsigned vimg, const unsigned (&vo)[4]) {
    const unsigned a0 = vimg + vo[2 * KB], a1 = vimg + vo[2 * KB + 1];
    ldsr<0>(v[0], a0); ldsr<4096>(v[1], a0);
    if constexpr (NDB == 4) { ldsr<8192>(v[2], a0); ldsr<12288>(v[3], a0); }
    ldsr<0>(v[NDB + 0], a1); ldsr<4096>(v[NDB + 1], a1);
    if constexpr (NDB == 4) { ldsr<8192>(v[NDB + 2], a1); ldsr<12288>(v[NDB + 3], a1); }
}
template <int NDB> __device__ __forceinline__ void wait_v(bf16x8 (&v)[2 * NDB]) { if constexpr (NDB == 4) lds_wait8(v); else lds_wait4(v); }
__device__ __forceinline__ void pack16(const f32x16& s, bf16x8& pf0, bf16x8& pf1) {
    u32x4 w0, w1;
    w0.x = cvtpk(s[0], s[1]); w0.y = cvtpk(s[2], s[3]); w0.z = cvtpk(s[4], s[5]); w0.w = cvtpk(s[6], s[7]);
    w1.x = cvtpk(s[8], s[9]); w1.y = cvtpk(s[10], s[11]); w1.z = cvtpk(s[12], s[13]); w1.w = cvtpk(s[14], s[15]);
    pf0 = __builtin_bit_cast(bf16x8, w0); pf1 = __builtin_bit_cast(bf16x8, w1);
}
__device__ __forceinline__ void near_bias(f32x16& s0, f32x16& s1, const ALAS float* bt, int qpos, int kbase, int hi) {
#pragma unroll
    for (int r = 0; r < 16; ++r) {
        const int d0 = qpos - (kbase + (r & 7) + 8 * hi + 16 * (r >> 3)), d1 = d0 - 32;
        const float b0 = bt[min(max(d0, 0), 255)], b1 = bt[min(max(d1, 0), 255)];
        s0[r] = d0 < 0 ? NEG : s0[r] + b0; s1[r] = d1 < 0 ? NEG : s1[r] + b1;
    }
}
__device__ __forceinline__ void anchor(f32x16& s0, f32x16& s1, float& mref) {
    float ta = __builtin_fmaxf(__builtin_fmaxf(s0[0], s0[1]), s1[0]), tb = __builtin_fmaxf(__builtin_fmaxf(s0[2], s0[3]), s1[1]); ta = __builtin_fmaxf(__builtin_fmaxf(ta, s1[2]), s1[3]);
#pragma unroll
    for (int r = 4; r < 16; r += 4) { ta = __builtin_fmaxf(__builtin_fmaxf(ta, s0[r]), s0[r + 1]); tb = __builtin_fmaxf(__builtin_fmaxf(tb, s0[r + 2]), s0[r + 3]);
        ta = __builtin_fmaxf(__builtin_fmaxf(ta, s1[r]), s1[r + 1]); tb = __builtin_fmaxf(__builtin_fmaxf(tb, s1[r + 2]), s1[r + 3]); }
    float tm = __builtin_fmaxf(ta, tb);
    tm = __builtin_fmaxf(tm, __shfl_xor(tm, 32));
    mref += tm;
#pragma unroll
    for (int r = 0; r < 16; ++r) { s0[r] -= tm; s1[r] -= tm; }
}
template <int NDB>
__device__ __forceinline__ void softmax_pv(f32x16& s0, f32x16& s1, float& mref, float& lsum, f32x16 (&o)[NDB], unsigned vimg, const unsigned (&vo)[4]) {
    bf16x8 va[2 * NDB], vb[2 * NDB];
    issue_v<NDB, 0>(va, vimg, vo);
    float ps = 0.f;
#pragma unroll
    for (int r = 0; r < 16; ++r) { s0[r] = ex2(s0[r]); ps += s0[r]; }
    bf16x8 pf0, pf1, pf2, pf3;
    pack16(s0, pf0, pf1);
    wait_v<NDB>(va);
    issue_v<NDB, 1>(vb, vimg, vo);
    __builtin_amdgcn_sched_barrier(0);
#pragma unroll
    for (int d = 0; d < NDB; ++d) o[d] = __builtin_amdgcn_mfma_f32_32x32x16_bf16(va[d], pf0, o[d], 0, 0, 0);
#pragma unroll
    for (int d = 0; d < NDB; ++d) o[d] = __builtin_amdgcn_mfma_f32_32x32x16_bf16(va[NDB + d], pf1, o[d], 0, 0, 0);
#pragma unroll
    for (int r = 0; r < 16; ++r) { s1[r] = ex2(s1[r]); ps += s1[r]; }
    pack16(s1, pf2, pf3);
#pragma unroll
    for (int i = 0; i < 2 * NDB; ++i) { __builtin_amdgcn_sched_group_barrier(0x008, 1, 0); __builtin_amdgcn_sched_group_barrier(0x002, (NDB == 4 ? 5 : 10), 0); }
    __builtin_amdgcn_sched_barrier(0);
    wait_v<NDB>(vb);
    __builtin_amdgcn_sched_barrier(0);
#pragma unroll
    for (int d = 0; d < NDB; ++d) o[d] = __builtin_amdgcn_mfma_f32_32x32x16_bf16(vb[d], pf2, o[d], 0, 0, 0);
#pragma unroll
    for (int d = 0; d < NDB; ++d) o[d] = __builtin_amdgcn_mfma_f32_32x32x16_bf16(vb[NDB + d], pf3, o[d], 0, 0, 0);
    lsum += ps;
    if (__any(ps > 1048576.0f)) {
        const float pt = ps + __shfl_xor(ps, 32); const float dl = pt > 1048576.0f ? floorf(__log2f(pt)) : 0.f, al = ex2(-dl); mref += dl; lsum *= al;
#pragma unroll
        for (int d = 0; d < NDB; ++d)
#pragma unroll
            for (int r = 0; r < 16; ++r) o[d][r] *= al;
    }
}

__device__ __forceinline__ void diff_unit(int b, int hd, int qb, const bf16_t* Q, const bf16_t* K, const bf16_t* VT, bf16_t* O, const float* biasd, float lam, const float* subg, ALAS unsigned char* lds) {
    int tid_ = threadIdx.x; asm volatile("" : "+v"(tid_));
    const int tid = tid_, lane = tid & 63, wid = __builtin_amdgcn_readfirstlane(tid >> 6), r32 = lane & 31, hi = lane >> 5;
    const int map = wid >> 2, w4 = wid & 3, q0 = qb * 128 + w4 * 32, qpos = q0 + r32;
    if (wid >= 4) __builtin_amdgcn_s_setprio(1);
    const size_t tok0 = (size_t)b * SEQ;
    ALAS float* btab = (ALAS float*)(lds + 65536);
    btab[tid] = biasd[(2 * hd) * 256 + tid];
    const ALAS float* bt = btab + map * 256;
    const float cb = biasd[(2 * hd + map) * 256 + 255];
    bf16x8 qf[4];
    { const bf16_t* qp = Q + (tok0 + qpos) * 1024 + (2 * hd + map) * 64 + hi * 8;
#pragma unroll
      for (int d0 = 0; d0 < 4; ++d0) qf[d0] = *(const bf16x8*)(qp + d0 * 16); }
    const int NT = 2 * (qb + 1);
    unsigned ko[4], vo[4];
    { const int kr_ = kperm(r32), ksw = (kr_ >> 1) & 7, vsw = (r32 >> 1) & 7;
#pragma unroll
      for (int i = 0; i < 4; ++i) { ko[i] = (unsigned)(kr_ * 128 + (((2 * i + hi) ^ ksw) << 4)); vo[i] = (unsigned)(r32 * 128 + (((2 * i + hi) ^ vsw) << 4)); } }
    const unsigned lds0 = (unsigned)(uintptr_t)lds;
    const bf16_t* gsrc[4];
    { const int rk = 8 * wid + (lane >> 3), ck = swz_src_chunk(rk, lane);
      gsrc[0] = K + (tok0 + rk) * 1024 + hd * 128 + ck * 8; gsrc[1] = gsrc[0] + 64;
      const int d0_ = 8 * wid + (lane >> 3), d1_ = 64 + d0_;
      gsrc[2] = VT + (size_t)(hd * 128 + d0_) * MTOK + tok0 + swz_src_chunk(d0_, lane) * 8; gsrc[3] = VT + (size_t)(hd * 128 + d1_) * MTOK + tok0 + swz_src_chunk(d1_, lane) * 8; }
#define DIFF_DMA(t, bufoff) do { const unsigned d_ = (unsigned)__builtin_amdgcn_readfirstlane((int)(lds0 + (bufoff) + wid * 1024)); \
        glds16(gsrc[0] + (size_t)(t) * 64 * 1024, d_); glds16(gsrc[1] + (size_t)(t) * 64 * 1024, d_ + 8192); glds16(gsrc[2] + (t) * 64, d_ + 16384); glds16(gsrc[3] + (t) * 64, d_ + 24576); } while (0)
    f32x16 o[4]; float mref = 0.f, lsum = 0.f;
#pragma unroll
    for (int d = 0; d < 4; ++d)
#pragma unroll
        for (int r = 0; r < 16; ++r) o[d][r] = 0.f;
    DIFF_DMA(0, 0);
    for (int t = 0; t < NT; ++t) {
        const unsigned bufo = (t & 1) * 32768;
        asm volatile("s_waitcnt vmcnt(0)" ::: "memory");
        __syncthreads();
        if (t + 1 < NT) DIFF_DMA(t + 1, 32768 - bufo);
        const int kbase = 64 * t;
        if (kbase <= q0 + 31) {
            const bool far = (q0 - (kbase + 63)) >= 128;
            f32x16 s0, s1; const float ci = (far ? cb : 0.f) - mref;
            qk_tile(s0, s1, ci, lds0 + bufo + map * 8192, ko, qf);
            if (!far) near_bias(s0, s1, bt, qpos, kbase, hi);
            if (t == 0) anchor(s0, s1, mref);
            softmax_pv<4>(s0, s1, mref, lsum, o, lds0 + bufo + 16384, vo);
        }
    }
#undef DIFF_DMA
    lsum += __shfl_xor(lsum, 32);
    const float inv = 1.0f / lsum;
    __syncthreads();
    ALAS float* X = (ALAS float*)lds;
    if (map == 1) {
#pragma unroll
        for (int d = 0; d < 4; ++d)
#pragma unroll
            for (int r = 0; r < 16; ++r) X[((w4 * 4 + d) * 16 + r) * 64 + lane] = o[d][r] * inv;
    }
    __syncthreads();
    if (map == 0) {
        float sq = 0.f;
#pragma unroll
        for (int d = 0; d < 4; ++d)
#pragma unroll
            for (int r = 0; r < 16; ++r) { const float a = o[d][r] * inv - lam * X[((w4 * 4 + d) * 16 + r) * 64 + lane]; o[d][r] = a; sq += a * a; }
        sq += __shfl_xor(sq, 32);
        const float rn = __builtin_amdgcn_rsqf(sq * (1.0f / 128.0f) + SUBLN_EPS) * 0.8f;
        bf16_t* op = O + (tok0 + qpos) * 1024 + hd * 128 + 4 * hi;
#pragma unroll
        for (int d = 0; d < 4; ++d)
#pragma unroll
            for (int a4 = 0; a4 < 4; ++a4) { const int c0 = d * 32 + 8 * a4; const pg8::f32x4 g4 = *(const pg8::f32x4*)(subg + c0 + 4 * hi); u32x2 w;
                w.x = cvtpk(o[d][4 * a4 + 0] * rn * g4[0], o[d][4 * a4 + 1] * rn * g4[1]); w.y = cvtpk(o[d][4 * a4 + 2] * rn * g4[2], o[d][4 * a4 + 3] * rn * g4[3]);
                *(u32x2*)(op + c0) = w; }
    }
    __builtin_amdgcn_s_setprio(0);
    __syncthreads();
}

__device__ __forceinline__ void moba_unit(int b, int h, int j, const bf16_t* Q, const bf16_t* K, const bf16_t* VT, bf16_t* O, const float* biasd, const float* kmean, ALAS unsigned char* lds) {
    int tid_ = threadIdx.x; asm volatile("" : "+v"(tid_));
    const int tid = tid_, lane = tid & 63, wid = __builtin_amdgcn_readfirstlane(tid >> 6), r32 = lane & 31, hi = lane >> 5;
    const int q0 = 256 * j + 32 * wid, qpos = q0 + r32;
    if (wid >= 4) __builtin_amdgcn_s_setprio(1);
    const size_t tok0 = (size_t)b * SEQ;
    ALAS float* bt = (ALAS float*)(lds + 32768);
    if (tid < 256) bt[tid] = biasd[h * 256 + tid];
    const float cb = biasd[h * 256 + 255];
    { const int n = tid >> 5, d2 = (tid & 31) * 2; const float* kmp = kmean + (size_t)(b * 16 + n) * 2048 + h * 64 + d2; const float v0 = kmp[0] + kmp[1024], v1 = kmp[1] + kmp[1025];
      const unsigned wh = cvtpk(v0, v1); const float h0 = __uint_as_float(wh << 16), h1 = __uint_as_float(wh & 0xffff0000u); const unsigned wl = cvtpk(v0 - h0, v1 - h1);
      *(ALAS unsigned*)(lds + 33792 + n * ROWB + d2 * 2) = wh; *(ALAS unsigned*)(lds + 36096 + n * ROWB + d2 * 2) = wl; }
    bf16x8 qf[4];
    { const bf16_t* qp = Q + (tok0 + qpos) * 1024 + h * 64 + hi * 8;
#pragma unroll
      for (int d0 = 0; d0 < 4; ++d0) qf[d0] = *(const bf16x8*)(qp + d0 * 16); }
    const int NT = 4 * (j + 1);
    unsigned ko[4], vo[4];
    { const int kr_ = kperm(r32), ksw = (kr_ >> 1) & 7, vsw = (r32 >> 1) & 7;
#pragma unroll
      for (int i = 0; i < 4; ++i) { ko[i] = (unsigned)(kr_ * 128 + (((2 * i + hi) ^ ksw) << 4)); vo[i] = (unsigned)(r32 * 128 + (((2 * i + hi) ^ vsw) << 4)); } }
    const unsigned lds0 = (unsigned)(uintptr_t)lds;
    const bf16_t* gk; const bf16_t* gv;
    { const int rr = 8 * wid + (lane >> 3), cc = swz_src_chunk(rr, lane);
      gk = K + (tok0 + rr) * 1024 + h * 64 + cc * 8; gv = VT + (size_t)(h * 64 + rr) * MTOK + tok0 + cc * 8; }
#define MOBA_KB(t) (((t) < 4) ? (256 * j + 64 * (t)) : (64 * ((t) - 4)))
#define MOBA_DMA(t, bufoff) do { const unsigned d_ = (unsigned)__builtin_amdgcn_readfirstlane((int)(lds0 + (bufoff) + wid * 1024)); const int kb_ = MOBA_KB(t); \
        glds16(gk + (size_t)kb_ * 1024, d_); glds16(gv + kb_, d_ + 8192); } while (0)
    __syncthreads();
    unsigned selmask = 0u;
    {
        f32x16 g;
#pragma unroll
        for (int r = 0; r < 16; ++r) g[r] = 0.f;
        const ALAS unsigned char* kp = lds + 33792 + (r32 & 15) * ROWB + hi * 16;
#pragma unroll
        for (int d0 = 0; d0 < 4; ++d0) {
            const bf16x8 ah = *(const ALAS bf16x8*)(kp + d0 * 32), al = *(const ALAS bf16x8*)(kp + 2304 + d0 * 32);
            g = __builtin_amdgcn_mfma_f32_32x32x16_bf16(ah, qf[d0], g, 0, 0, 0);
            g = __builtin_amdgcn_mfma_f32_32x32x16_bf16(al, qf[d0], g, 0, 0, 0);
        }
        float gv[16];
#pragma unroll
        for (int r = 0; r < 8; ++r) { const float own = g[r], oth = __shfl_xor(own, 32); const int n0 = (r & 3) + 8 * (r >> 2);
            gv[n0] = hi ? oth : own; gv[n0 + 4] = hi ? own : oth; }
#pragma unroll
        for (int n = 0; n < 16; ++n) gv[n] = (n < j) ? gv[n] : -INFINITY;
#pragma unroll
        for (int n = 0; n < 16; ++n) { int rank = 0;
#pragma unroll
            for (int m = 0; m < 16; ++m) { if (m == n) continue; rank += (gv[m] > gv[n] || (gv[m] == gv[n] && m < n)) ? 1 : 0; }
#ifdef MOBA_DBG_FIXEDSEL
            rank = ((n + qpos) & 3) ? 99 : 0;
#endif
            if (n < j && rank < MOBA_DBG_TOPK) selmask |= (1u << n); }
    }
    f32x16 o[2]; float mref = 0.f, lsum = 0.f;
#pragma unroll
    for (int d = 0; d < 2; ++d)
#pragma unroll
        for (int r = 0; r < 16; ++r) o[d][r] = 0.f;
    MOBA_DMA(0, 0);
    for (int t = 0; t < NT; ++t) {
        const unsigned bufo = (t & 1) * 16384;
        asm volatile("s_waitcnt vmcnt(0)" ::: "memory");
        __syncthreads();
        if (t + 1 < NT) MOBA_DMA(t + 1, 16384 - bufo);
        const bool own = t < 4; const int n = own ? j : ((t - 4) >> 2); const int kbase = MOBA_KB(t);
        const bool sel = own ? true : (((selmask >> n) & 1u) != 0u);
        const bool active = own ? (64 * t <= 32 * wid + 31) : (__any(sel) != 0);
        if (active) {
            const bool nearb = (q0 - (kbase + 63)) < 128;
            f32x16 s0, s1; const float ci = sel ? ((nearb ? 0.f : cb) - mref) : NEG;
            qk_tile(s0, s1, ci, lds0 + bufo, ko, qf);
            if (nearb) near_bias(s0, s1, bt, qpos, kbase, hi);
            if (t == 0) anchor(s0, s1, mref);
            softmax_pv<2>(s0, s1, mref, lsum, o, lds0 + bufo + 8192, vo);
        }
    }
#undef MOBA_DMA
#undef MOBA_KB
    lsum += __shfl_xor(lsum, 32);
    const float inv = 1.0f / lsum;
    bf16_t* op = O + (tok0 + qpos) * 1024 + h * 64 + 4 * hi;
#pragma unroll
    for (int d = 0; d < 2; ++d)
#pragma unroll
        for (int a4 = 0; a4 < 4; ++a4) { u32x2 w; w.x = cvtpk(o[d][4 * a4 + 0] * inv, o[d][4 * a4 + 1] * inv); w.y = cvtpk(o[d][4 * a4 + 2] * inv, o[d][4 * a4 + 3] * inv);
            *(u32x2*)(op + d * 32 + 8 * a4) = w; }
    __builtin_amdgcn_s_setprio(0);
    __syncthreads();
}
}

using pg8::bf16_t;
typedef float f32x4 __attribute__((ext_vector_type(4)));
typedef unsigned v4u __attribute__((ext_vector_type(4)));
#define LAS __attribute__((address_space(3)))
constexpr size_t MiB = 1u << 20;
#define XB_TMO      128
#define XB_XCNT(j)  (256  + 64 * (j))
#define XB_XSUB(j)  (1280 + 64 * (j))
#define XB_XGEN(j)  (2304 + 64 * (j))
#define XB_TOP      3328
#define XB_TOPGEN   3392
#define XCD_BAR_WORDS 3456
#define XB_SPIN_CAP (1u << 18)

__device__ __forceinline__ unsigned xb_ld(unsigned* p)              { return __hip_atomic_load(p, __ATOMIC_RELAXED, __HIP_MEMORY_SCOPE_AGENT); }
__device__ __forceinline__ unsigned xb_add(unsigned* p, unsigned v) { return __hip_atomic_fetch_add(p, v, __ATOMIC_RELAXED, __HIP_MEMORY_SCOPE_AGENT); }
__device__ __forceinline__ unsigned xb_xcc_id() { return (unsigned)__builtin_amdgcn_s_getreg((3 << 11) | 20) & 0xFu; }
#define XB_SPIN(cond, bar) do { unsigned _sp = 0; while (cond) { __builtin_amdgcn_s_sleep(1); \
    if ((++_sp & 255u) == 0u) { if (xb_ld(&(bar)[XB_TMO])) break; if (_sp > XB_SPIN_CAP) { atomicAdd(&(bar)[XB_TMO], 1u); break; } } } } while (0)

struct XcdBarrier {
    unsigned* bar; unsigned x;
    volatile LAS unsigned* st;
};

__device__ __forceinline__ XcdBarrier xcd_barrier_post(unsigned* bar, volatile LAS unsigned* st) {
    XcdBarrier b; b.bar = bar; b.x = xb_xcc_id(); b.st = st;
    if (threadIdx.x == 0) (void)xb_add(&bar[XB_XCNT(b.x)], 1u);
    return b;
}
__device__ __forceinline__ void xcd_barrier_complete(unsigned* bar, unsigned x, unsigned& nloc, unsigned& nx) {
    const unsigned G = gridDim.x * gridDim.y * gridDim.z;
    unsigned sum, cnt, mine, sp = 0u;
    for (;;) {
        sum = 0u; cnt = 0u; mine = 0u;
#pragma unroll
        for (unsigned j = 0; j < 16; ++j) { const unsigned c = xb_ld(&bar[XB_XCNT(j)]); sum += c; cnt += (c > 0u) ? 1u : 0u; mine = (j == x) ? c : mine; }
        if (sum == G) break;
        __builtin_amdgcn_s_sleep(1);
        if ((++sp & 255u) == 0u) { if (xb_ld(&bar[XB_TMO])) break; if (sp > XB_SPIN_CAP) { atomicAdd(&bar[XB_TMO], 1u); break; } }
    }
    nloc = mine > 0u ? mine : 1u; nx = cnt > 0u ? cnt : 1u;
}

__device__ __forceinline__ void xcd_barrier(const XcdBarrier& b) {
    asm volatile("s_waitcnt vmcnt(0)" ::: "memory");
    __syncthreads();
    if (threadIdx.x == 0) {
        unsigned* bar = b.bar;
        __builtin_amdgcn_s_waitcnt(0);
        unsigned nloc = b.st[0], nx = b.st[1];
        if (nloc == 0u) { xcd_barrier_complete(bar, b.x, nloc, nx); b.st[0] = nloc; b.st[1] = nx; }
        const unsigned old = xb_add(&bar[XB_XSUB(b.x)], 1u);
        const unsigned gen = old / nloc;
        if (old + 1u == (gen + 1u) * nloc) {
            __builtin_amdgcn_fence(__ATOMIC_RELEASE, "agent");
            asm volatile("s_waitcnt vmcnt(0)" ::: "memory");
            const unsigned og = xb_add(&bar[XB_TOP], 1u);
            const unsigned tg = og / nx;
            if (og + 1u == (tg + 1u) * nx) xb_add(&bar[XB_TOPGEN], 1u);
            else XB_SPIN(xb_ld(&bar[XB_TOPGEN]) == tg, bar);
            __builtin_amdgcn_fence(__ATOMIC_ACQUIRE, "agent");
            xb_add(&bar[XB_XGEN(b.x)], 1u);
            asm volatile("s_waitcnt vmcnt(0)" ::: "memory");
        } else {
            XB_SPIN(xb_ld(&bar[XB_XGEN(b.x)]) == gen, bar);
            __builtin_amdgcn_fence(__ATOMIC_ACQUIRE, "agent");
            asm volatile("s_waitcnt vmcnt(0)" ::: "memory");
        }
    }
    __syncthreads();
}

constexpr size_t WS_SS = 406 * MiB;
constexpr size_t WS_CTL = 0;
constexpr size_t WS_KMEAN = 1 * MiB;
constexpr size_t WS_BIASD = 2 * MiB;
constexpr size_t WS_WIN = 4 * MiB;
constexpr size_t WS_WOUT = 48 * MiB;
constexpr size_t WS_WQKV = 70 * MiB;
constexpr size_t WS_WO = 82 * MiB;
constexpr size_t WS_XA = 86 * MiB;
constexpr size_t WS_Q = 150 * MiB, WS_K = 214 * MiB, WS_VT = 278 * MiB, WS_O = 342 * MiB;
constexpr size_t WS_ACT = 150 * MiB;
constexpr size_t WS_END = 420 * MiB;
constexpr int LDS_BYTES = 135168;
constexpr int N_PHASES = 16;

struct Params {
    const float *x, *rel_bias, *norm_g, *final_g, *w_in, *w_out, *dq_w, *d_lam, *d_subg, *d_wo, *mq_w, *m_wo;
    float* out; unsigned char* ws; long long ph_lo, ph_hi;
};

__device__ __forceinline__ float wave_sum(float v) {
#pragma unroll
    for (int o = 1; o < 64; o <<= 1) v += __shfl_xor(v, o);
    return v;
}
__device__ __forceinline__ unsigned pk2(float lo, float hi) { return pg8::cvt_pk_bf16(lo, hi); }

__device__ __forceinline__ void xpose_item(const float* W, int K, int N, bf16_t* WT, int k0, int n0, int drow0, const float* g, float cs, LAS float* scr, int lane) {
    float wv[32], gv[32];
#pragma unroll
    for (int i = 0; i < 32; ++i) { const int kk = 2 * i + (lane >> 5); wv[i] = W[(size_t)(k0 + kk) * N + n0 + (lane & 31)]; gv[i] = g ? g[k0 + kk] * cs : cs; }
#pragma unroll
    for (int i = 0; i < 32; ++i) { const int kk = 2 * i + (lane >> 5); scr[kk * 33 + (lane & 31)] = wv[i] * gv[i]; }
    asm volatile("s_waitcnt lgkmcnt(0)" ::: "memory");
    const int c = lane & 7;
#pragma unroll
    for (int jj = 0; jj < 4; ++jj) { const int n = (lane >> 3) + 8 * jj; const LAS float* s = scr + (8 * c) * 33 + n;
        v4u o; o.x = pk2(s[0 * 33], s[1 * 33]); o.y = pk2(s[2 * 33], s[3 * 33]); o.z = pk2(s[4 * 33], s[5 * 33]); o.w = pk2(s[6 * 33], s[7 * 33]);
        *(v4u*)(WT + (size_t)(drow0 + n) * K + k0 + 8 * c) = o; }
    asm volatile("s_waitcnt lgkmcnt(0)" ::: "memory");
}

__device__ __forceinline__ void prologue(const Params& p, LAS unsigned char* lds) {
    int tid_ = threadIdx.x; asm volatile("" : "+v"(tid_));
    const int tid = tid_, lane = tid & 63, wave = __builtin_amdgcn_readfirstlane(tid >> 6);
    const int gw = blockIdx.x * 8 + wave, NGW = gridDim.x * 8;
    unsigned char* ws = p.ws;
    LAS float* scr = (LAS float*)(lds + wave * 16384);
    constexpr int I_IN = 16 * 176, I_OUT = 44 * 32, I_QKV = 16 * 96, I_WO = 16 * 32;
    constexpr int NITEMS = 4 * I_IN + 4 * I_OUT + 2 * I_QKV + 2 * I_WO;
    for (int it = gw; it < NITEMS; it += NGW) {
        int r = it;
        if (r < 4 * I_IN) { const int mi = r / I_IN, item = r % I_IN, kb = item / 176, nb = item % 176, n0 = nb * 32; const int l = mi >> 1, s = mi & 1;
            const int isup = n0 >= FF ? 1 : 0, f = n0 - isup * FF, drow0 = 256 * (f >> 7) + 128 * isup + (f & 127);
            xpose_item(p.w_in + (size_t)mi * 1024 * FF2, 1024, FF2, (bf16_t*)(ws + WS_WIN) + (size_t)mi * FF2 * 1024, kb * 64, n0, drow0, p.norm_g + (l * 3 + (s ? 2 : 0)) * 1024, 1.0f, scr, lane); continue; }
        r -= 4 * I_IN;
        if (r < 4 * I_OUT) { const int mi = r / I_OUT, item = r % I_OUT, kb = item / 32, nb = item % 32;
            xpose_item(p.w_out + (size_t)mi * FF * 1024, FF, 1024, (bf16_t*)(ws + WS_WOUT) + (size_t)mi * 1024 * FF, kb * 64, nb * 32, nb * 32, nullptr, 1.0f, scr, lane); continue; }
        r -= 4 * I_OUT;
        if (r < 2 * I_QKV) { const int l = r / I_QKV, item = r % I_QKV, kb = item / 96, nb = item % 96, n0 = nb * 32;
            xpose_item(l ? p.mq_w : p.dq_w, 1024, 3072, (bf16_t*)(ws + WS_WQKV) + (size_t)l * 3072 * 1024, kb * 64, n0, n0, p.norm_g + (l * 3 + 1) * 1024, n0 < 1024 ? QSCALE : 1.0f, scr, lane); continue; }
        r -= 2 * I_QKV;
        { const int l = r / I_WO, item = r % I_WO, kb = item / 32, nb = item % 32;
            xpose_item(l ? p.m_wo : p.d_wo, 1024, 1024, (bf16_t*)(ws + WS_WO) + (size_t)l * 1024 * 1024, kb * 64, nb * 32, nb * 32, nullptr, 1.0f, scr, lane); }
    }
    float* ss = (float*)(ws + WS_SS);
    for (int m0 = gw; m0 < MTOK; m0 += 2 * NGW) {
        f32x4 v[2][4];
#pragma unroll
        for (int rr = 0; rr < 2; ++rr) { const int m = m0 + rr * NGW; if (m < MTOK) { const f32x4* xr = (const f32x4*)(p.x + (size_t)m * 1024) + lane;
#pragma unroll
            for (int jj = 0; jj < 4; ++jj) v[rr][jj] = xr[64 * jj]; } }
#pragma unroll
        for (int rr = 0; rr < 2; ++rr) { const int m = m0 + rr * NGW; if (m < MTOK) { unsigned long long* o8 = (unsigned long long*)((bf16_t*)(ws + WS_XA) + (size_t)m * 1024) + lane; float s = 0.f;
#pragma unroll
            for (int jj = 0; jj < 4; ++jj) { const f32x4 w = v[rr][jj]; s += (w[0] * w[0] + w[1] * w[1]) + (w[2] * w[2] + w[3] * w[3]);
                o8[64 * jj] = (unsigned long long)pk2(w[0], w[1]) | ((unsigned long long)pk2(w[2], w[3]) << 32); }
            s = wave_sum(s);
            if (lane < 16) ss[(size_t)m * 16 + lane] = lane == 0 ? s : 0.f; } }
    }
    const int gt = blockIdx.x * 512 + tid, NGT = gridDim.x * 512;
    float* bd = (float*)(ws + WS_BIASD);
    for (int i = gt; i < 16 * 256; i += NGT) { const int m = i >> 8, d = i & 255; int bk;
        if (d < 16) bk = d; else { bk = 16 + (int)(logf((float)d / 16.0f) / logf(8.0f) * 16.0f); bk = bk > 31 ? 31 : bk; }
        bd[i] = p.rel_bias[bk * 16 + m] * LOG2E; }
}

__device__ __forceinline__ void final_norm(const Params& p) {
    int tid_ = threadIdx.x; asm volatile("" : "+v"(tid_));
    const int tid = tid_, lane = tid & 63, wave = tid >> 6; const int gw = blockIdx.x * 8 + wave, NGW = gridDim.x * 8;
    const float* ss = (const float*)(p.ws + WS_SS) + (size_t)6 * MTOK * 16;
    const bf16_t* XA = (const bf16_t*)(p.ws + WS_XA);
    f32x4 g[2][2];
#pragma unroll
    for (int jj = 0; jj < 2; ++jj) { g[jj][0] = *(const f32x4*)(p.final_g + 512 * jj + 8 * lane); g[jj][1] = *(const f32x4*)(p.final_g + 512 * jj + 8 * lane + 4); }
    for (int m0 = gw; m0 < MTOK; m0 += 2 * NGW) {
        v4u v[2][2]; f32x4 sp[2];
#pragma unroll
        for (int rr = 0; rr < 2; ++rr) { const int m = m0 + rr * NGW; if (m < MTOK) { const bf16_t* xr = XA + (size_t)m * 1024 + 8 * lane; sp[rr] = *(const f32x4*)(ss + (size_t)m * 16 + 4 * (lane & 3));
            v[rr][0] = *(const v4u*)xr; v[rr][1] = *(const v4u*)(xr + 512); } }
#pragma unroll
        for (int rr = 0; rr < 2; ++rr) { const int m = m0 + rr * NGW; if (m < MTOK) { float* orow = p.out + (size_t)m * 1024 + 8 * lane;
            float s4 = (sp[rr][0] + sp[rr][1]) + (sp[rr][2] + sp[rr][3]); s4 += __shfl_xor(s4, 1); s4 += __shfl_xor(s4, 2);
            const float rs = __builtin_amdgcn_rsqf(s4 * (1.0f / 1024.0f) + 1e-6f);
#pragma unroll
            for (int jj = 0; jj < 2; ++jj) { const v4u w = v[rr][jj]; f32x4 a, b;
                a[0] = __uint_as_float(w.x << 16); a[1] = __uint_as_float(w.x & 0xffff0000u); a[2] = __uint_as_float(w.y << 16); a[3] = __uint_as_float(w.y & 0xffff0000u);
                b[0] = __uint_as_float(w.z << 16); b[1] = __uint_as_float(w.z & 0xffff0000u); b[2] = __uint_as_float(w.w << 16); b[3] = __uint_as_float(w.w & 0xffff0000u);
                *(f32x4*)(orow + 512 * jj) = a * rs * g[jj][0]; *(f32x4*)(orow + 512 * jj + 4) = b * rs * g[jj][1]; } } }
    }
}

template <class Epi>
__device__ __forceinline__ void run_gemm(LAS unsigned char* lds, const bf16_t* A, const bf16_t* Bt, int M, int N, int K, const Epi& E) {
    int bx_ = (int)blockIdx.x; asm volatile("" : "+s"(bx_));
    pg8::Gemm g{A, Bt, M, N, K}; pg8::StaticOrder S; S.init(M, N, (int)gridDim.x, bx_);
#if USE_FAST_GEMM
    pg8::gemm_phase<Epi, pg8::StaticOrder, GEMM_ALIGN_EPI, true>(lds, g, S, E);
#else
    pg8::gemm_simple<Epi, pg8::StaticOrder>(g, S, E);
#endif
}

__global__ void __launch_bounds__(512, 2) fwd_kernel(Params p) {
    extern __shared__ __attribute__((aligned(16))) unsigned char lds_raw[];
    LAS unsigned char* lds = (LAS unsigned char*)lds_raw;
    cg::grid_group grid = cg::this_grid();
    unsigned char* ws = p.ws;
    const int lo = (int)p.ph_lo, hi = (int)p.ph_hi;
    float* ss = (float*)(ws + WS_SS);
    bf16_t* XA = (bf16_t*)(ws + WS_XA); bf16_t* ACT = (bf16_t*)(ws + WS_ACT);
    bf16_t* Qb = (bf16_t*)(ws + WS_Q); bf16_t* Kb = (bf16_t*)(ws + WS_K); bf16_t* VTb = (bf16_t*)(ws + WS_VT); bf16_t* Ob = (bf16_t*)(ws + WS_O);
    { volatile LAS unsigned* misc = (volatile LAS unsigned*)(lds + 131072); if (threadIdx.x < 32) misc[threadIdx.x] = 0u; }
    __syncthreads();
    XcdBarrier bar = xcd_barrier_post((unsigned*)(ws + WS_CTL), (volatile LAS unsigned*)(lds + 131072 + 32));
    if (p.ph_lo < 0) grid.sync();
    const int G = gridDim.x; const int vcu = (G % 8 == 0) ? ((int)blockIdx.x % 8) * (G / 8) + (int)blockIdx.x / 8 : (int)blockIdx.x;
#define IN(k) (lo <= (k) && (k) < hi)
#define SEAM(k) do { if (IN(k) && IN((k) + 1)) { xcd_barrier(bar); } } while (0)
    for (int rep = 0; rep < REPEAT_PRO; ++rep)
    if (IN(0)) { prologue(p, lds); __syncthreads(); }
    SEAM(0);
    for (int l = 0; l < 2; ++l) {
        const int pb = 1 + 7 * l;
        const bf16_t* Win0 = (const bf16_t*)(ws + WS_WIN) + (size_t)(2 * l) * FF2 * 1024; const bf16_t* Win1 = Win0 + (size_t)FF2 * 1024;
        const bf16_t* Wout0 = (const bf16_t*)(ws + WS_WOUT) + (size_t)(2 * l) * 1024 * FF; const bf16_t* Wout1 = Wout0 + (size_t)1024 * FF;
        const bf16_t* Wqkv = (const bf16_t*)(ws + WS_WQKV) + (size_t)l * 3072 * 1024; const bf16_t* Wo = (const bf16_t*)(ws + WS_WO) + (size_t)l * 1024 * 1024;
        for (int rep = 0; rep < REPEAT_UP; ++rep)
        if (IN(pb + 0)) { pg8::EpiSwiglu E{ACT, ss + (size_t)(3 * l) * MTOK * 16}; run_gemm(lds, XA, Win0, MTOK, FF2, 1024, E); }
        SEAM(pb + 0);
        if (IN(pb + 1)) { if (l == 0) { pg8::EpiResid<true> E{p.x, XA, ss + (size_t)(3 * l + 1) * MTOK * 16, 0.5f}; run_gemm(lds, ACT, Wout0, MTOK, 1024, FF, E); }
                           else { pg8::EpiResid<false> E{nullptr, XA, ss + (size_t)(3 * l + 1) * MTOK * 16, 0.5f}; run_gemm(lds, ACT, Wout0, MTOK, 1024, FF, E); } }
        SEAM(pb + 1);
        if (IN(pb + 2)) {
            { pg8::EpiQK E{Qb, Kb, ss + (size_t)(3 * l + 1) * MTOK * 16, l == 1 ? (float*)(ws + WS_KMEAN) : nullptr}; run_gemm(lds, XA, Wqkv, MTOK, 2048, 1024, E); }
            { pg8::EpiVT E{VTb, ss + (size_t)(3 * l + 1) * MTOK * 16}; run_gemm(lds, Wqkv + (size_t)2048 * 1024, XA, 1024, MTOK, 1024, E); }
        }
        SEAM(pb + 2);
        for (int rep = 0; rep < REPEAT_ATTN; ++rep)
        if (IN(pb + 3) && !(SKIP_ATTN_MASK & (1 << l))) {
            const float* biasd = (const float*)(ws + WS_BIASD);
            if (l == 0) {
                int lane = threadIdx.x & 63; asm volatile("" : "+v"(lane)); const float* lp = p.d_lam;
                const float s1 = wave_sum(lp[lane] * lp[64 + lane]), s2 = wave_sum(lp[128 + lane] * lp[192 + lane]);
                const float lam = expf(s1) - expf(s2) + 0.2f;
                for (int U = vcu; U < 2048; U += G) { const int c = U & 255, i = U >> 8, bh = c >> 2, s = c & 3, pr = i >> 1; const int qb = (i & 1) ? (8 * pr + 7 - s) : (8 * pr + s);
                    att::diff_unit(bh >> 3, bh & 7, qb, Qb, Kb, VTb, Ob, biasd, lam, p.d_subg, lds); }
            } else {
                for (int U = vcu; U < 2048; U += G) { const int c = U & 255, i = U >> 8, bh = c >> 1, s = c & 1, pr = i >> 1; const int j = (i & 1) ? (4 * pr + 3 - s) : (4 * pr + s);
                    att::moba_unit(bh >> 4, bh & 15, j, Qb, Kb, VTb, Ob, biasd, (const float*)(ws + WS_KMEAN), lds); }
            }
        }
        SEAM(pb + 3);
        if (IN(pb + 4)) { pg8::EpiResid<false> E{nullptr, XA, ss + (size_t)(3 * l + 2) * MTOK * 16, 1.0f}; run_gemm(lds, Ob, Wo, MTOK, 1024, 1024, E); }
        SEAM(pb + 4);
        if (IN(pb + 5)) { pg8::EpiSwiglu E{ACT, ss + (size_t)(3 * l + 2) * MTOK * 16}; run_gemm(lds, XA, Win1, MTOK, FF2, 1024, E); }
        SEAM(pb + 5);
        if (IN(pb + 6)) { pg8::EpiResid<false> E{nullptr, XA, ss + (size_t)(3 * l + 3) * MTOK * 16, 0.5f}; run_gemm(lds, ACT, Wout1, MTOK, 1024, FF, E); }
        SEAM(pb + 6);
    }
    if (IN(15)) final_norm(p);
#undef IN
#undef SEAM
}

extern "C" void kernel_launch(void* const* d_in, const int* in_sizes, int n_in, void* d_out, int out_size, void* d_ws, size_t ws_size, hipStream_t stream) {
    static int grid = 0;
    if (grid == 0) {
        if (n_in != 12 || in_sizes[0] != MTOK * 1024 || out_size != MTOK * 1024 || ws_size < WS_END) { fprintf(stderr, "kernel_launch: unexpected shapes (n_in %d, in0 %d, out %d, ws %zu); nothing launched\n", n_in, n_in > 0 ? in_sizes[0] : -1, out_size, ws_size); grid = -1; return; }
        int dev = 0, cus = 0, per_cu = 0;
        if (hipGetDevice(&dev) != hipSuccess || hipDeviceGetAttribute(&cus, hipDeviceAttributeMultiprocessorCount, dev) != hipSuccess) { grid = -1; return; }
        if (hipFuncSetAttribute((const void*)fwd_kernel, hipFuncAttributeMaxDynamicSharedMemorySize, LDS_BYTES) != hipSuccess) { fprintf(stderr, "kernel_launch: hipFuncSetAttribute failed\n"); grid = -1; return; }
        if (hipOccupancyMaxActiveBlocksPerMultiprocessor(&per_cu, (const void*)fwd_kernel, 512, LDS_BYTES) != hipSuccess || per_cu < 1) { fprintf(stderr, "kernel_launch: occupancy query gives %d\n", per_cu); per_cu = 1; }
        (void)hipGetLastError();
        grid = cus * 1;
    }
    if (grid < 0) return;
    if (hipMemsetAsync((char*)d_ws + WS_CTL, 0, 65536, stream) != hipSuccess) { fprintf(stderr, "kernel_launch: memset of the barrier words failed\n"); return; }
    Params p{};
    p.x = (const float*)d_in[0]; p.rel_bias = (const float*)d_in[1]; p.norm_g = (const float*)d_in[2]; p.final_g = (const float*)d_in[3];
    p.w_in = (const float*)d_in[4]; p.w_out = (const float*)d_in[5]; p.dq_w = (const float*)d_in[6]; p.d_lam = (const float*)d_in[7];
    p.d_subg = (const float*)d_in[8]; p.d_wo = (const float*)d_in[9]; p.mq_w = (const float*)d_in[10]; p.m_wo = (const float*)d_in[11];
    p.out = (float*)d_out; p.ws = (unsigned char*)d_ws;
#if N_LAUNCH_MODE == 1
    p.ph_lo = 0; p.ph_hi = N_PHASES;
    void* args[] = {&p};
    hipError_t e = hipLaunchCooperativeKernel((const void*)fwd_kernel, dim3(grid), dim3(512), args, LDS_BYTES, stream);
    if (e != hipSuccess) fprintf(stderr, "kernel_launch: cooperative launch failed: %s (grid %d)\n", hipGetErrorString(e), grid);
#else
    for (int ph = 0; ph < N_PHASES; ++ph) { p.ph_lo = ph; p.ph_hi = ph + 1; hipLaunchKernelGGL(fwd_kernel, dim3(grid), dim3(512), LDS_BYTES, stream, p); }
#endif
}
```

```cpp
#include <hip/hip_runtime.h>
#include <hip/hip_cooperative_groups.h>
#include <cstdio>
#include <cstdint>
namespace cg = cooperative_groups;

#ifndef USE_FAST_GEMM
#define USE_FAST_GEMM 1
#endif
#ifndef SKIP_ATTN_MASK
#define SKIP_ATTN_MASK 0
#endif
#ifndef MOBA_LAG
#define MOBA_LAG 1
#endif
#ifndef DIFF_FUSED
#define DIFF_FUSED 0
#endif
#ifndef DIFF_LAG
#define DIFF_LAG 0
#endif
#ifndef GEMM_ALIGN_EPI
#define GEMM_ALIGN_EPI true
#endif
#ifndef REPEAT_ATTN
#define REPEAT_ATTN 1
#endif
#ifndef REPEAT_PRO
#define REPEAT_PRO 1
#endif
#ifndef REPEAT_SEAM
#define REPEAT_SEAM 1
#endif
#ifndef REPEAT_UP
#define REPEAT_UP 1
#endif
#ifndef MOBA_DBG_TOPK
#define MOBA_DBG_TOPK 3
#endif
#ifndef N_LAUNCH_MODE
#define N_LAUNCH_MODE 1
#endif

constexpr int BATCH = 8, SEQ = 4096, DM = 1024, MTOK = BATCH * SEQ, FF = 2816, FF2 = 2 * FF;
constexpr float LOG2E = 1.4426950408889634f;
constexpr float QSCALE = 0.125f * LOG2E;
constexpr float RMS_EPS = 1e-6f, SUBLN_EPS = 1e-5f;

namespace pg8 {
#define PG8_LAS __attribute__((address_space(3)))
typedef unsigned short bf16_t;
typedef short bf16x8 __attribute__((ext_vector_type(8)));
typedef float f32x4 __attribute__((ext_vector_type(4)));
typedef unsigned u32x4 __attribute__((ext_vector_type(4)));
constexpr int BM = 256, BK = 64, HALF = 128, HTB = HALF * BK * 2  , STAGE_BYTES = 8 * HTB, NXCD = 8, WGM = 8;

__host__ __device__ __forceinline__ int lds_byte(int r, int c) { const int st = (r >> 4) * 2 + (c >> 5), rr = r & 15, cc = c & 31, ob = rr * 64 + cc * 2; return st * 1024 + (ob ^ (((ob >> 9) & 1) << 5)); }
__host__ __device__ __forceinline__ void stage_rc(int b, int& R, int& C) { const int st = b / 1024, sb = b % 1024, swz = sb ^ (((sb >> 9) & 1) << 5); R = (st >> 1) * 16 + swz / 64; C = (st & 1) * 32 + (swz % 64) / 2; }
__host__ __device__ __forceinline__ int perm32(int rho) { const int n = rho >> 4, i = rho & 15; return 8 * (i >> 2) + 4 * n + (i & 3); }

struct Unit { int pm, pn; };
struct Gemm { const bf16_t* A; const bf16_t* Bt; int M, N, K; };

struct StaticOrder {
    int nM, nN, nwg, G, c;
    __host__ __device__ void init(int M, int N, int G_, int c_) { nM = M / BM; nN = N / BM; nwg = nM * nN; G = G_; c = c_; }
    __host__ __device__ bool next(int i, Unit& u) const {
        const long L = (long)i * G + c; if (L >= nwg) return false;
        int wgid = (int)L; { const int q = nwg / NXCD, r = nwg % NXCD, xcd = wgid % NXCD, off = wgid / NXCD; wgid = (xcd < r ? xcd * (q + 1) : r * (q + 1) + (xcd - r) * q) + off; }
        const int nig = WGM * nN, gid = wgid / nig, fm = gid * WGM, gsz = (nM - fm) < WGM ? (nM - fm) : WGM;
        u.pm = fm + ((wgid % nig) % gsz); u.pn = (wgid % nig) / gsz; return true;
    }
    __device__ __forceinline__ void a_ready(const Unit&) const {}
    __device__ __forceinline__ void done(const Unit&) const {}
};
typedef unsigned u32x2 __attribute__((ext_vector_type(2)));
typedef float cvt_f32x2 __attribute__((ext_vector_type(2))); typedef __bf16 cvt_bf16x2 __attribute__((ext_vector_type(2)));
__device__ __forceinline__ unsigned cvt_pk_bf16(float lo, float hi) { cvt_f32x2 v = {lo, hi}; cvt_bf16x2 b = __builtin_convertvector(v, cvt_bf16x2); return __builtin_bit_cast(unsigned, b); }
__device__ __forceinline__ u32x2 pack4(f32x4 v) { u32x2 w; w.x = cvt_pk_bf16(v[0], v[1]); w.y = cvt_pk_bf16(v[2], v[3]); return w; }
__device__ __forceinline__ float rstd_of(const float* ssrow) { const f32x4* q = (const f32x4*)ssrow; const f32x4 a = q[0], b = q[1], c = q[2], d = q[3];
    const float ss = ((a[0] + a[1]) + (a[2] + a[3])) + ((b[0] + b[1]) + (b[2] + b[3])) + (((c[0] + c[1]) + (c[2] + c[3])) + ((d[0] + d[1]) + (d[2] + d[3])));
    const float r = __builtin_amdgcn_rsqf(ss * (1.0f / 1024.0f) + 1e-6f); asm volatile("" ::: "memory"); return r; }

__device__ __forceinline__ float rstd_row4(const float* ssrow, int fq) { const f32x4 a = *(const f32x4*)(ssrow + 4 * fq); float ss = (a[0] + a[1]) + (a[2] + a[3]);
    ss += __shfl_xor(ss, 16); ss += __shfl_xor(ss, 32); return __builtin_amdgcn_rsqf(ss * (1.0f / 1024.0f) + 1e-6f); }
struct EpiSwiglu {
    static constexpr bool PERM = true, AFTER_DRAIN = false;
    bf16_t* out; const float* ss;
    __device__ __forceinline__ void operator()(const f32x4 (&acc)[2][2][4][2], const Unit& u, int wr, int wc, int fr, int fq) const {
#pragma unroll
        for (int ai = 0; ai < 2; ++ai)
#pragma unroll
            for (int m = 0; m < 4; ++m) {
                const int row = u.pm * BM + ai * HALF + wr * 64 + m * 16 + fr; const float rs = rstd_row4(ss + (size_t)row * 16, fq);
                bf16_t* rowp = out + (size_t)row * 2816 + u.pn * 128 + wc * 32 + fq * 8;
                u32x4 w;
                const float rsl = rs * (-1.4426950408889634f), rs2 = rs * rs;
#pragma unroll
                for (int n = 0; n < 2; ++n) {
                    const f32x4 ta = acc[ai][0][m][n] * rsl, gu = acc[ai][0][m][n] * acc[ai][1][m][n]; f32x4 t;
                    t[0] = __builtin_amdgcn_exp2f(ta[0]); t[1] = __builtin_amdgcn_exp2f(ta[1]); t[2] = __builtin_amdgcn_exp2f(ta[2]); t[3] = __builtin_amdgcn_exp2f(ta[3]);
                    const f32x4 dn = t + 1.0f; f32x4 r;
                    r[0] = __builtin_amdgcn_rcpf(dn[0]); r[1] = __builtin_amdgcn_rcpf(dn[1]); r[2] = __builtin_amdgcn_rcpf(dn[2]); r[3] = __builtin_amdgcn_rcpf(dn[3]);
                    const f32x4 h = gu * (r * rs2);
                    const u32x2 pk = pack4(h); if (n == 0) { w.x = pk.x; w.y = pk.y; } else { w.z = pk.x; w.w = pk.y; } }
                *(u32x4*)rowp = w;
            }
    }
};
template <bool F32IN>
struct EpiResid {
    static constexpr bool PERM = true, AFTER_DRAIN = false;
    const float* hin; bf16_t* xa; float* ssout; float alpha;
    __device__ __forceinline__ size_t goff(const Unit& u, int g, int wr, int wc, int fr, int fq) const { return (size_t)(u.pm * BM + (g >> 2) * HALF + wr * 64 + (g & 3) * 16 + fr) * 1024 + u.pn * BM + wc * 32 + fq * 8; }
    struct Grp { f32x4 f[4]; };
    __device__ __forceinline__ void gload(Grp& h, size_t off) const {
        if constexpr (F32IN) { h.f[0] = *(const f32x4*)(hin + off); h.f[1] = *(const f32x4*)(hin + off + 4); h.f[2] = *(const f32x4*)(hin + off + HALF); h.f[3] = *(const f32x4*)(hin + off + HALF + 4); }
        else { const u32x4 a = *(const u32x4*)(xa + off), b = *(const u32x4*)(xa + off + HALF); h.f[0] = __builtin_bit_cast(f32x4, a); h.f[2] = __builtin_bit_cast(f32x4, b); }
    }
    __device__ __forceinline__ void unpack(const Grp& h, int bj, f32x4& v0, f32x4& v1) const {
        if constexpr (F32IN) { v0 = h.f[2 * bj]; v1 = h.f[2 * bj + 1]; }
        else { const u32x4 w = __builtin_bit_cast(u32x4, h.f[2 * bj]);
            v0[0] = __uint_as_float(w.x << 16); v0[1] = __uint_as_float(w.x & 0xffff0000u); v0[2] = __uint_as_float(w.y << 16); v0[3] = __uint_as_float(w.y & 0xffff0000u);
            v1[0] = __uint_as_float(w.z << 16); v1[1] = __uint_as_float(w.z & 0xffff0000u); v1[2] = __uint_as_float(w.w << 16); v1[3] = __uint_as_float(w.w & 0xffff0000u); }
    }
    __device__ __forceinline__ void operator()(const f32x4 (&acc)[2][2][4][2], const Unit& u, int wr, int wc, int fr, int fq) const {
        Grp h[2];
        gload(h[0], goff(u, 0, wr, wc, fr, fq));
#pragma unroll
        for (int g = 0; g < 8; ++g) {
            const int ai = g >> 2, m = g & 3; const size_t off = goff(u, g, wr, wc, fr, fq);
            if (g < 7) gload(h[(g + 1) & 1], goff(u, g + 1, wr, wc, fr, fq));
            float sq = 0.f;
#pragma unroll
            for (int bj = 0; bj < 2; ++bj) { const size_t o = off + bj * HALF; f32x4 h0, h1; unpack(h[g & 1], bj, h0, h1);
                h0 = h0 + acc[ai][bj][m][0] * alpha; h1 = h1 + acc[ai][bj][m][1] * alpha;
                const u32x2 p0 = pack4(h0), p1 = pack4(h1); u32x4 w; w.x = p0.x; w.y = p0.y; w.z = p1.x; w.w = p1.y; *(u32x4*)(xa + o) = w;
                sq += ((h0[0] * h0[0] + h0[1] * h0[1]) + (h0[2] * h0[2] + h0[3] * h0[3])) + ((h1[0] * h1[0] + h1[1] * h1[1]) + (h1[2] * h1[2] + h1[3] * h1[3])); }
            sq += __shfl_xor(sq, 16); sq += __shfl_xor(sq, 32);
            if (fq == 0) ssout[(size_t)(u.pm * BM + ai * HALF + wr * 64 + m * 16 + fr) * 16 + u.pn * 4 + wc] = sq;
            asm volatile("" ::: "memory");
        }
    }
};
struct EpiQK {
    static constexpr bool PERM = true, AFTER_DRAIN = false;
    bf16_t* Qo; bf16_t* Ko; const float* ss; float* kmean;
    __device__ __forceinline__ void operator()(const f32x4 (&acc)[2][2][4][2], const Unit& u, int wr, int wc, int fr, int fq) const {
        const int colt = u.pn * BM; bf16_t* base = colt < 1024 ? Qo : Ko; const int cc = (colt & 1023) + wc * 32 + fq * 8;
        const bool km = (kmean != nullptr) && colt >= 1024;
        f32x4 cs[2][2];
#pragma unroll
        for (int bj = 0; bj < 2; ++bj)
#pragma unroll
            for (int n = 0; n < 2; ++n) cs[bj][n] = (f32x4){0.f, 0.f, 0.f, 0.f};
#pragma unroll
        for (int ai = 0; ai < 2; ++ai)
#pragma unroll
            for (int m = 0; m < 4; ++m) {
                const int row = u.pm * BM + ai * HALF + wr * 64 + m * 16 + fr; const float rs = rstd_row4(ss + (size_t)row * 16, fq);
                bf16_t* rowp = base + (size_t)row * 1024 + cc;
#pragma unroll
                for (int bj = 0; bj < 2; ++bj) { const f32x4 v0 = acc[ai][bj][m][0] * rs, v1 = acc[ai][bj][m][1] * rs; const u32x2 p0 = pack4(v0), p1 = pack4(v1);
                    u32x4 w; w.x = p0.x; w.y = p0.y; w.z = p1.x; w.w = p1.y; *(u32x4*)(rowp + bj * HALF) = w; cs[bj][0] = cs[bj][0] + v0; cs[bj][1] = cs[bj][1] + v1; }
            }
        if (km) {
#pragma unroll
            for (int bj = 0; bj < 2; ++bj)
#pragma unroll
                for (int n = 0; n < 2; ++n)
#pragma unroll
                    for (int i = 0; i < 4; ++i) { float v = cs[bj][n][i]; v += __shfl_xor(v, 1); v += __shfl_xor(v, 2); v += __shfl_xor(v, 4); v += __shfl_xor(v, 8);
                        if (fr == 0) kmean[(size_t)(u.pm * 2 + wr) * 1024 + cc + bj * HALF + n * 4 + i] = v; }
        }
    }
};
struct EpiVT {
    static constexpr bool PERM = false, AFTER_DRAIN = false;
    bf16_t* VT; const float* ss;
    __device__ __forceinline__ void operator()(const f32x4 (&acc)[2][2][4][2], const Unit& u, int wr, int wc, int fr, int fq) const {
#pragma unroll
        for (int bj = 0; bj < 2; ++bj)
#pragma unroll
            for (int n = 0; n < 2; ++n) {
                const int tok = u.pn * BM + bj * HALF + wc * 32 + n * 16 + fq * 4; f32x4 rs; rs[0] = rstd_of(ss + (size_t)tok * 16); rs[1] = rstd_of(ss + (size_t)tok * 16 + 16); rs[2] = rstd_of(ss + (size_t)tok * 16 + 32); rs[3] = rstd_of(ss + (size_t)tok * 16 + 48);
#pragma unroll
                for (int ai = 0; ai < 2; ++ai)
#pragma unroll
                    for (int m = 0; m < 4; ++m) { const int c = u.pm * BM + ai * HALF + wr * 64 + m * 16 + fr; *(u32x2*)(VT + (size_t)c * 32768 + tok) = pack4(acc[ai][bj][m][n] * rs); }
            }
    }
};

template <class Epi, class Sched>
__device__ __forceinline__ void gemm_simple(const Gemm g, const Sched& S, const Epi& E) {
    static_assert(!Epi::PERM, "gemm_simple stages no permuted weight rows");
    int tid_ = threadIdx.x; asm volatile("" : "+v"(tid_));
    const int tid = tid_, wid = __builtin_amdgcn_readfirstlane(tid >> 6), lane = tid & 63, wr = wid >> 2, wc = wid & 3, fr = lane & 15, fq = lane >> 4;
    const int K = g.K; Unit u;
    for (int ui = 0; S.next(ui, u); ++ui) {
        f32x4 acc[2][2][4][2];
#pragma unroll
        for (int a = 0; a < 2; ++a)
#pragma unroll
            for (int b = 0; b < 2; ++b)
#pragma unroll
                for (int m = 0; m < 4; ++m)
#pragma unroll
                    for (int n = 0; n < 2; ++n) acc[a][b][m][n] = (f32x4){0.f, 0.f, 0.f, 0.f};
        const bf16_t* Ab = g.A + (size_t)(u.pm * BM + wr * 64 + fr) * K + fq * 8;
        const bf16_t* Bb = g.Bt + (size_t)(u.pn * BM + wc * 32 + fr) * K + fq * 8;
        for (int k0 = 0; k0 < K; k0 += 32) {
            bf16x8 af[2][4], bfr[2][2];
#pragma unroll
            for (int ai = 0; ai < 2; ++ai)
#pragma unroll
                for (int m = 0; m < 4; ++m) af[ai][m] = *(const bf16x8*)(Ab + (size_t)(ai * HALF + m * 16) * K + k0);
#pragma unroll
            for (int bj = 0; bj < 2; ++bj)
#pragma unroll
                for (int n = 0; n < 2; ++n) bfr[bj][n] = *(const bf16x8*)(Bb + (size_t)(bj * HALF + n * 16) * K + k0);
#pragma unroll
            for (int ai = 0; ai < 2; ++ai)
#pragma unroll
                for (int bj = 0; bj < 2; ++bj)
#pragma unroll
                    for (int m = 0; m < 4; ++m)
#pragma unroll
                        for (int n = 0; n < 2; ++n) acc[ai][bj][m][n] = __builtin_amdgcn_mfma_f32_16x16x32_bf16(bfr[bj][n], af[ai][m], acc[ai][bj][m][n], 0, 0, 0);
        }
        E(acc, u, wr, wc, fr, fq);
    }
}

template <class Epi, class Sched, bool ALIGN_EPI = false, bool SP2 = false>
__device__ __forceinline__ void gemm_phase(PG8_LAS unsigned char* lds, const Gemm g, const Sched& S, const Epi& E) {
    int tid_ = threadIdx.x; asm volatile("" : "+v"(tid_));
    const int tid = tid_, wid = __builtin_amdgcn_readfirstlane(tid >> 6), lane = tid & 63, wr = wid >> 2, wc = wid & 3, fr = lane & 15, fq = lane >> 4;
    const int K = g.K, nt = K / BK;
    unsigned voffA[2], voffB[2];
#pragma unroll
    for (int i = 0; i < 2; ++i) { int R, C; stage_rc(tid * 16 + i * 8192, R, C); const int Rb = Epi::PERM ? ((R & ~31) + perm32(R & 31)) : R;
        voffA[i] = (unsigned)(R * K + C) * 2u; voffB[i] = (unsigned)(Rb * K + C) * 2u; }
    const size_t kstep = (size_t)(BK * 2);
    const size_t hstep = (size_t)HALF * K * 2;
    const size_t tstep = 2 * hstep;
    const unsigned ldsw = (unsigned)wid * 1024u;
    const int aoff = lds_byte(wr * 64 + fr, fq * 8), boff = lds_byte(wc * 32 + fr, fq * 8);
#define PG8_SA(b, h) (((b) * 2 + (h)) * HTB)
#define PG8_SB(b, h) ((4 + (b) * 2 + (h)) * HTB)
#define PG8_STAGE(bufoff, gbase, voff) do { _Pragma("unroll") for (int _i = 0; _i < 2; ++_i) \
        __builtin_amdgcn_global_load_lds((const unsigned*)((const char*)(gbase) + (voff)[_i]), (PG8_LAS unsigned*)(lds + (bufoff) + ldsw + _i * 8192), 16, 0, 0); } while (0)
#define PG8_LDA(dst, b, h) do { _Pragma("unroll") for (int m = 0; m < 4; ++m) _Pragma("unroll") for (int k = 0; k < 2; ++k) dst[m][k] = *(const PG8_LAS bf16x8*)(lds + PG8_SA(b, h) + aoff + m * 2048 + k * 1024); } while (0)
#define PG8_LDB(dst, b, h) do { _Pragma("unroll") for (int n = 0; n < 2; ++n) _Pragma("unroll") for (int k = 0; k < 2; ++k) dst[n][k] = *(const PG8_LAS bf16x8*)(lds + PG8_SB(b, h) + boff + n * 2048 + k * 1024); } while (0)
#define PG8_MMA(ai, bj, At, Bt) do { __builtin_amdgcn_s_setprio(1); _Pragma("unroll") for (int m = 0; m < 4; ++m) _Pragma("unroll") for (int n = 0; n < 2; ++n) _Pragma("unroll") for (int k = 0; k < 2; ++k) \
        acc[ai][bj][m][n] = __builtin_amdgcn_mfma_f32_16x16x32_bf16(Bt[n][k], At[m][k], acc[ai][bj][m][n], 0, 0, 0); __builtin_amdgcn_s_setprio(0); } while (0)
#define PG8_WAIT_V(n) asm volatile("s_waitcnt vmcnt(" #n ")" ::: "memory")
#define PG8_WAIT_L(n) asm volatile("s_waitcnt lgkmcnt(" #n ")" ::: "memory")
#define PG8_BAR __builtin_amdgcn_s_barrier()
#define PG8_SCHED __builtin_amdgcn_sched_barrier(0)
    Unit cur, nxt; int ui = 0;
    if (!S.next(0, cur)) return;
    f32x4 acc[2][2][4][2];
#pragma unroll
    for (int a = 0; a < 2; ++a)
#pragma unroll
        for (int b = 0; b < 2; ++b)
#pragma unroll
            for (int m = 0; m < 4; ++m)
#pragma unroll
                for (int n = 0; n < 2; ++n) acc[a][b][m][n] = (f32x4){0.f, 0.f, 0.f, 0.f};
    bf16x8 At[4][2], B0[2][2], B1[2][2];
    const char* cA = (const char*)g.A + (size_t)cur.pm * tstep; const char* cB = (const char*)g.Bt + (size_t)cur.pn * tstep;
    S.a_ready(cur);
    if constexpr (SP2) {
        PG8_STAGE(PG8_SB(0, 0), cB, voffB); PG8_STAGE(PG8_SB(0, 1), cB + hstep, voffB); PG8_STAGE(PG8_SA(0, 0), cA, voffA); PG8_STAGE(PG8_SA(0, 1), cA + hstep, voffA);
        if (wr == 1) PG8_BAR;
        PG8_WAIT_V(2); PG8_BAR;
        PG8_STAGE(PG8_SB(1, 0), cB + kstep, voffB); PG8_STAGE(PG8_SA(1, 0), cA + kstep, voffA); PG8_STAGE(PG8_SB(1, 1), cB + hstep + kstep, voffB);
        PG8_WAIT_V(6); PG8_BAR;
    } else {
        PG8_STAGE(PG8_SB(0, 0), cB, voffB); PG8_STAGE(PG8_SA(0, 0), cA, voffA); PG8_STAGE(PG8_SB(0, 1), cB + hstep, voffB); PG8_STAGE(PG8_SA(0, 1), cA + hstep, voffA);
        if (wr == 1) PG8_BAR;
        PG8_WAIT_V(4); PG8_BAR;
        PG8_STAGE(PG8_SB(1, 0), cB + kstep, voffB); PG8_STAGE(PG8_SA(1, 0), cA + kstep, voffA); PG8_STAGE(PG8_SB(1, 1), cB + hstep + kstep, voffB);
        PG8_WAIT_V(6); PG8_BAR;
    }
    for (;;) {
        const bool has_next = S.next(ui + 1, nxt);
        const char* nA = has_next ? (const char*)g.A + (size_t)nxt.pm * tstep : cA; const char* nB = has_next ? (const char*)g.Bt + (size_t)nxt.pn * tstep : cB;
        for (int t = 0; t < nt; t += 2) {
            const bool last = (t == nt - 2);
            const char* a1 = cA + (size_t)(t + 1) * kstep;
            const char* a2 = last ? nA : cA + (size_t)(t + 2) * kstep; const char* b2 = last ? nB : cB + (size_t)(t + 2) * kstep;
            const char* a3 = a2 + kstep; const char* b3 = b2 + kstep;
            if (last && has_next) S.a_ready(nxt);
            if constexpr (SP2) {
            PG8_LDB(B0, 0, 0); PG8_LDB(B1, 0, 1); PG8_SCHED; PG8_LDA(At, 0, 0); PG8_STAGE(PG8_SA(1, 1), a1 + hstep, voffA);
            PG8_WAIT_V(8); PG8_WAIT_L(0); PG8_BAR; PG8_MMA(0, 0, At, B0); PG8_MMA(0, 1, At, B1); PG8_BAR; PG8_SCHED;
            PG8_LDA(At, 0, 1); PG8_STAGE(PG8_SB(0, 0), b2, voffB); PG8_STAGE(PG8_SB(0, 1), b2 + hstep, voffB); PG8_STAGE(PG8_SA(0, 0), a2, voffA);
            PG8_WAIT_V(8); PG8_WAIT_L(0); PG8_BAR; PG8_MMA(1, 0, At, B0); PG8_MMA(1, 1, At, B1); PG8_BAR; PG8_SCHED;
            PG8_LDB(B0, 1, 0); PG8_LDB(B1, 1, 1); PG8_SCHED; PG8_LDA(At, 1, 0); PG8_STAGE(PG8_SA(0, 1), a2 + hstep, voffA);
            PG8_WAIT_V(8); PG8_WAIT_L(0); PG8_BAR; PG8_MMA(0, 0, At, B0); PG8_MMA(0, 1, At, B1); PG8_BAR; PG8_SCHED;
            PG8_LDA(At, 1, 1); PG8_STAGE(PG8_SB(1, 0), b3, voffB); PG8_STAGE(PG8_SB(1, 1), b3 + hstep, voffB); PG8_STAGE(PG8_SA(1, 0), a3, voffA);
            PG8_WAIT_V(8); PG8_WAIT_L(0); PG8_BAR; PG8_MMA(1, 0, At, B0); PG8_MMA(1, 1, At, B1); PG8_BAR; PG8_SCHED;
            } else {
            PG8_LDB(B0, 0, 0); PG8_SCHED; PG8_LDA(At, 0, 0); PG8_STAGE(PG8_SA(1, 1), a1 + hstep, voffA);
            PG8_WAIT_L(8); PG8_BAR; PG8_WAIT_L(0); PG8_MMA(0, 0, At, B0); PG8_BAR; PG8_SCHED;
            PG8_LDB(B1, 0, 1); PG8_STAGE(PG8_SB(0, 0), b2, voffB);
            PG8_BAR; PG8_WAIT_L(0); PG8_MMA(0, 1, At, B1); PG8_BAR;
            PG8_LDA(At, 0, 1); PG8_STAGE(PG8_SA(0, 0), a2, voffA);
            PG8_BAR; PG8_WAIT_L(0); PG8_MMA(1, 0, At, B0); PG8_BAR; PG8_SCHED;
            PG8_STAGE(PG8_SB(0, 1), b2 + hstep, voffB);
            PG8_WAIT_V(6); PG8_BAR; PG8_MMA(1, 1, At, B1); PG8_BAR;
            PG8_LDB(B0, 1, 0); PG8_SCHED; PG8_LDA(At, 1, 0); PG8_STAGE(PG8_SA(0, 1), a2 + hstep, voffA);
            PG8_WAIT_L(8); PG8_BAR; PG8_WAIT_L(0); PG8_MMA(0, 0, At, B0); PG8_BAR; PG8_SCHED;
            PG8_LDB(B1, 1, 1); PG8_STAGE(PG8_SB(1, 0), b3, voffB);
            PG8_BAR; PG8_WAIT_L(0); PG8_MMA(0, 1, At, B1); PG8_BAR;
            PG8_LDA(At, 1, 1); PG8_STAGE(PG8_SA(1, 0), a3, voffA);
            PG8_BAR; PG8_WAIT_L(0); PG8_MMA(1, 0, At, B0); PG8_BAR; PG8_SCHED;
            PG8_STAGE(PG8_SB(1, 1), b3 + hstep, voffB);
            PG8_WAIT_V(6); PG8_BAR; PG8_MMA(1, 1, At, B1); PG8_BAR;
            }
        }
        if constexpr (ALIGN_EPI) { if (wr == 0) PG8_BAR; }
        if constexpr (!Epi::AFTER_DRAIN) { E(acc, cur, wr, wc, fr, fq); S.done(cur); }
        if (!has_next) break;
#pragma unroll
        for (int a = 0; a < 2; ++a)
#pragma unroll
            for (int b = 0; b < 2; ++b)
#pragma unroll
                for (int m = 0; m < 4; ++m)
#pragma unroll
                    for (int n = 0; n < 2; ++n) acc[a][b][m][n] = (f32x4){0.f, 0.f, 0.f, 0.f};
        cur = nxt; cA = nA; cB = nB; ++ui;
        if constexpr (ALIGN_EPI) { if (wr == 1) PG8_BAR; }
    }
    PG8_WAIT_V(0);
    if constexpr (!ALIGN_EPI) { if (wr == 0) PG8_BAR; }
    PG8_BAR;
    if constexpr (Epi::AFTER_DRAIN) { E.fused(acc, cur, wr, wc, fr, fq, lds, wid, lane); S.done(cur); }
#undef PG8_SA
#undef PG8_SB
#undef PG8_STAGE
#undef PG8_LDA
#undef PG8_LDB
#undef PG8_MMA
#undef PG8_WAIT_V
#undef PG8_WAIT_L
#undef PG8_BAR
#undef PG8_SCHED
}
}
namespace att {
using pg8::bf16_t; using pg8::bf16x8; using pg8::u32x4; using pg8::u32x2;
typedef float f32x16 __attribute__((ext_vector_type(16)));
#define ALAS __attribute__((address_space(3)))
constexpr int ROWB = 144;
constexpr float NEG = -1e30f;
__device__ __forceinline__ int kperm(int i) { return (i & 19) | ((i & 4) << 1) | ((i & 8) >> 1); }
__device__ __forceinline__ int crow(int r, int hi) { return (r & 3) + 8 * (r >> 2) + 4 * hi; }
__device__ __forceinline__ unsigned cvtpk(float lo, float hi) { return pg8::cvt_pk_bf16(lo, hi); }
__device__ __forceinline__ float ex2(float x) { return __builtin_amdgcn_exp2f(x); }

template <int OFF> __device__ __forceinline__ void ldsr(bf16x8& d, unsigned a) { asm volatile("ds_read_b128 %0, %1 offset:%c2" : "=v"(d) : "v"(a), "i"(OFF) : "memory"); }
__device__ __forceinline__ void lds_wait8(bf16x8 (&a)[8]) { asm volatile("s_waitcnt lgkmcnt(0)" : "+v"(a[0]), "+v"(a[1]), "+v"(a[2]), "+v"(a[3]), "+v"(a[4]), "+v"(a[5]), "+v"(a[6]), "+v"(a[7]) :: "memory"); }
__device__ __forceinline__ void lds_wait4(bf16x8 (&a)[4]) { asm volatile("s_waitcnt lgkmcnt(0)" : "+v"(a[0]), "+v"(a[1]), "+v"(a[2]), "+v"(a[3]) :: "memory"); }
__device__ __forceinline__ void qk_tile(f32x16& s0, f32x16& s1, float ci, const ALAS unsigned char* Kb, const bf16x8 (&qf)[4], int r32, int hi) {
    const unsigned p0 = (unsigned)(uintptr_t)(Kb + kperm(r32) * ROWB + hi * 16);
    bf16x8 a[8];
    ldsr<0>(a[0], p0); ldsr<32 * ROWB>(a[1], p0); ldsr<32>(a[2], p0); ldsr<32 * ROWB + 32>(a[3], p0);
    ldsr<64>(a[4], p0); ldsr<32 * ROWB + 64>(a[5], p0); ldsr<96>(a[6], p0); ldsr<32 * ROWB + 96>(a[7], p0);
#pragma unroll
    for (int r = 0; r < 16; ++r) { s0[r] = ci; s1[r] = ci; }
    lds_wait8(a); __builtin_amdgcn_sched_barrier(0);
#pragma unroll
    for (int d0 = 0; d0 < 4; ++d0) {
        s0 = __builtin_amdgcn_mfma_f32_32x32x16_bf16(a[2 * d0], qf[d0], s0, 0, 0, 0);
        s1 = __builtin_amdgcn_mfma_f32_32x32x16_bf16(a[2 * d0 + 1], qf[d0], s1, 0, 0, 0);
    }
}
template <int NDB, int KB>
__device__ __forceinline__ void issue_v(bf16x8 (&v)[2 * NDB], unsigned vp) {
    ldsr<0 * 32 * ROWB + 64 * KB>(v[0], vp); ldsr<1 * 32 * ROWB + 64 * KB>(v[1], vp);
    if constexpr (NDB == 4) { ldsr<2 * 32 * ROWB + 64 * KB>(v[2], vp); ldsr<3 * 32 * ROWB + 64 * KB>(v[3], vp); }
    ldsr<0 * 32 * ROWB + 64 * KB + 32>(v[NDB + 0], vp); ldsr<1 * 32 * ROWB + 64 * KB + 32>(v[NDB + 1], vp);
    if constexpr (NDB == 4) { ldsr<2 * 32 * ROWB + 64 * KB + 32>(v[NDB + 2], vp); ldsr<3 * 32 * ROWB + 64 * KB + 32>(v[NDB + 3], vp); }
}
template <int NDB> __device__ __forceinline__ void wait_v(bf16x8 (&v)[2 * NDB]) { if constexpr (NDB == 4) lds_wait8(v); else lds_wait4(v); }
__device__ __forceinline__ void pack16(const f32x16& s, bf16x8& pf0, bf16x8& pf1) {
    u32x4 w0, w1;
    w0.x = cvtpk(s[0], s[1]); w0.y = cvtpk(s[2], s[3]); w0.z = cvtpk(s[4], s[5]); w0.w = cvtpk(s[6], s[7]);
    w1.x = cvtpk(s[8], s[9]); w1.y = cvtpk(s[10], s[11]); w1.z = cvtpk(s[12], s[13]); w1.w = cvtpk(s[14], s[15]);
    pf0 = __builtin_bit_cast(bf16x8, w0); pf1 = __builtin_bit_cast(bf16x8, w1);
}
__device__ __forceinline__ void near_bias(f32x16& s0, f32x16& s1, const ALAS float* bt, int qpos, int kbase, int hi) {
#pragma unroll
    for (int r = 0; r < 16; ++r) {
        const int d0 = qpos - (kbase + (r & 7) + 8 * hi + 16 * (r >> 3)), d1 = d0 - 32;
        const float b0 = bt[min(max(d0, 0), 255)], b1 = bt[min(max(d1, 0), 255)];
        s0[r] = d0 < 0 ? NEG : s0[r] + b0; s1[r] = d1 < 0 ? NEG : s1[r] + b1;
    }
}
__device__ __forceinline__ void anchor(f32x16& s0, f32x16& s1, float& mref) {
    float ta = __builtin_fmaxf(__builtin_fmaxf(s0[0], s0[1]), s1[0]), tb = __builtin_fmaxf(__builtin_fmaxf(s0[2], s0[3]), s1[1]); ta = __builtin_fmaxf(__builtin_fmaxf(ta, s1[2]), s1[3]);
#pragma unroll
    for (int r = 4; r < 16; r += 4) { ta = __builtin_fmaxf(__builtin_fmaxf(ta, s0[r]), s0[r + 1]); tb = __builtin_fmaxf(__builtin_fmaxf(tb, s0[r + 2]), s0[r + 3]);
        ta = __builtin_fmaxf(__builtin_fmaxf(ta, s1[r]), s1[r + 1]); tb = __builtin_fmaxf(__builtin_fmaxf(tb, s1[r + 2]), s1[r + 3]); }
    float tm = __builtin_fmaxf(ta, tb);
    tm = __builtin_fmaxf(tm, __shfl_xor(tm, 32));
    mref += tm;
#pragma unroll
    for (int r = 0; r < 16; ++r) { s0[r] -= tm; s1[r] -= tm; }
}
template <int NDB>
__device__ __forceinline__ void softmax_pv(f32x16& s0, f32x16& s1, float& mref, float& lsum, f32x16 (&o)[NDB], const ALAS unsigned char* Vb, int r32, int hi) {
    const unsigned vp = (unsigned)(uintptr_t)(Vb + r32 * ROWB + hi * 16);
    bf16x8 va[2 * NDB], vb[2 * NDB];
    issue_v<NDB, 0>(va, vp);
    float ps = 0.f;
#pragma unroll
    for (int r = 0; r < 16; ++r) { s0[r] = ex2(s0[r]); ps += s0[r]; }
    bf16x8 pf0, pf1, pf2, pf3;
    pack16(s0, pf0, pf1);
    wait_v<NDB>(va);
    issue_v<NDB, 1>(vb, vp);
    __builtin_amdgcn_sched_barrier(0);
#pragma unroll
    for (int d = 0; d < NDB; ++d) o[d] = __builtin_amdgcn_mfma_f32_32x32x16_bf16(va[d], pf0, o[d], 0, 0, 0);
#pragma unroll
    for (int d = 0; d < NDB; ++d) o[d] = __builtin_amdgcn_mfma_f32_32x32x16_bf16(va[NDB + d], pf1, o[d], 0, 0, 0);
#pragma unroll
    for (int r = 0; r < 16; ++r) { s1[r] = ex2(s1[r]); ps += s1[r]; }
    pack16(s1, pf2, pf3);
#pragma unroll
    for (int i = 0; i < 2 * NDB; ++i) { __builtin_amdgcn_sched_group_barrier(0x008, 1, 0); __builtin_amdgcn_sched_group_barrier(0x002, (NDB == 4 ? 5 : 10), 0); }
    __builtin_amdgcn_sched_barrier(0);
    wait_v<NDB>(vb);
    __builtin_amdgcn_sched_barrier(0);
#pragma unroll
    for (int d = 0; d < NDB; ++d) o[d] = __builtin_amdgcn_mfma_f32_32x32x16_bf16(vb[d], pf2, o[d], 0, 0, 0);
#pragma unroll
    for (int d = 0; d < NDB; ++d) o[d] = __builtin_amdgcn_mfma_f32_32x32x16_bf16(vb[NDB + d], pf3, o[d], 0, 0, 0);
    lsum += ps;
    if (__any(ps > 1048576.0f)) {
        const float pt = ps + __shfl_xor(ps, 32); const float dl = pt > 1048576.0f ? floorf(__log2f(pt)) : 0.f, al = ex2(-dl); mref += dl; lsum *= al;
#pragma unroll
        for (int d = 0; d < NDB; ++d)
#pragma unroll
            for (int r = 0; r < 16; ++r) o[d][r] *= al;
    }
}

__device__ __forceinline__ void diff_unit(int b, int hd, int qb, const bf16_t* Q, const bf16_t* K, const bf16_t* VT, bf16_t* O, const float* biasd, float lam, const float* subg, ALAS unsigned char* lds) {
    int tid_ = threadIdx.x; asm volatile("" : "+v"(tid_));
    const int tid = tid_, lane = tid & 63, wid = __builtin_amdgcn_readfirstlane(tid >> 6), r32 = lane & 31, hi = lane >> 5;
    const int map = wid >> 2, w4 = wid & 3, q0 = qb * 128 + w4 * 32, qpos = q0 + r32;
    if (wid >= 4) __builtin_amdgcn_s_setprio(1);
    const size_t tok0 = (size_t)b * SEQ;
    ALAS float* btab = (ALAS float*)(lds + 73728);
    btab[tid] = biasd[(2 * hd) * 256 + tid];
    const ALAS float* bt = btab + map * 256;
    const float cb = biasd[(2 * hd + map) * 256 + 255];
    bf16x8 qf[4];
    { const bf16_t* qp = Q + (tok0 + qpos) * 1024 + (2 * hd + map) * 64 + hi * 8;
#pragma unroll
      for (int d0 = 0; d0 < 4; ++d0) qf[d0] = *(const bf16x8*)(qp + d0 * 16); }
    const int NT = 2 * (qb + 1);
    const bf16_t* kg[2]; const bf16_t* vg[2]; int kl[2], vl[2];
#pragma unroll
    for (int i = 0; i < 2; ++i) { const int c = tid + 512 * i; const int key = c >> 4, part = c & 15;
        kg[i] = K + (tok0 + key) * 1024 + hd * 128 + part * 8; kl[i] = ((part >> 3) * 64 + key) * ROWB + (part & 7) * 16;
        const int d = c >> 3, pv = c & 7; vg[i] = VT + (size_t)(hd * 128 + d) * MTOK + tok0 + pv * 8; vl[i] = 18432 + d * ROWB + pv * 16; }
    u32x4 kr[2], vr[2];
#pragma unroll
    for (int i = 0; i < 2; ++i) { kr[i] = *(const u32x4*)(kg[i]); vr[i] = *(const u32x4*)(vg[i]); }
    f32x16 o[4]; float mref = 0.f, lsum = 0.f;
#pragma unroll
    for (int d = 0; d < 4; ++d)
#pragma unroll
        for (int r = 0; r < 16; ++r) o[d][r] = 0.f;
    for (int t = 0; t < NT; ++t) {
        ALAS unsigned char* buf = lds + (t & 1) * 36864;
#pragma unroll
        for (int i = 0; i < 2; ++i) { *(ALAS u32x4*)(buf + kl[i]) = kr[i]; *(ALAS u32x4*)(buf + vl[i]) = vr[i]; }
        __syncthreads();
        if (t + 1 < NT) {
#pragma unroll
            for (int i = 0; i < 2; ++i) { kr[i] = *(const u32x4*)(kg[i] + (size_t)(t + 1) * 64 * 1024); vr[i] = *(const u32x4*)(vg[i] + (t + 1) * 64); }
        }
        const int kbase = 64 * t;
        if (kbase <= q0 + 31) {
            const bool far = (q0 - (kbase + 63)) >= 128;
            f32x16 s0, s1; const float ci = (far ? cb : 0.f) - mref;
            qk_tile(s0, s1, ci, buf + map * 9216, qf, r32, hi);
            if (!far) near_bias(s0, s1, bt, qpos, kbase, hi);
            if (t == 0) anchor(s0, s1, mref);
            softmax_pv<4>(s0, s1, mref, lsum, o, buf + 18432, r32, hi);
        }
    }
    lsum += __shfl_xor(lsum, 32);
    const float inv = 1.0f / lsum;
    __syncthreads();
    ALAS float* X = (ALAS float*)lds;
    if (map == 1) {
#pragma unroll
        for (int d = 0; d < 4; ++d)
#pragma unroll
            for (int r = 0; r < 16; ++r) X[((w4 * 4 + d) * 16 + r) * 64 + lane] = o[d][r] * inv;
    }
    __syncthreads();
    if (map == 0) {
        float sq = 0.f;
#pragma unroll
        for (int d = 0; d < 4; ++d)
#pragma unroll
            for (int r = 0; r < 16; ++r) { const float a = o[d][r] * inv - lam * X[((w4 * 4 + d) * 16 + r) * 64 + lane]; o[d][r] = a; sq += a * a; }
        sq += __shfl_xor(sq, 32);
        const float rn = __builtin_amdgcn_rsqf(sq * (1.0f / 128.0f) + SUBLN_EPS) * 0.8f;
        bf16_t* op = O + (tok0 + qpos) * 1024 + hd * 128 + 4 * hi;
#pragma unroll
        for (int d = 0; d < 4; ++d)
#pragma unroll
            for (int a4 = 0; a4 < 4; ++a4) { const int c0 = d * 32 + 8 * a4; const pg8::f32x4 g4 = *(const pg8::f32x4*)(subg + c0 + 4 * hi); u32x2 w;
                w.x = cvtpk(o[d][4 * a4 + 0] * rn * g4[0], o[d][4 * a4 + 1] * rn * g4[1]); w.y = cvtpk(o[d][4 * a4 + 2] * rn * g4[2], o[d][4 * a4 + 3] * rn * g4[3]);
                *(u32x2*)(op + c0) = w; }
    }
    __builtin_amdgcn_s_setprio(0);
    __syncthreads();
}

__device__ __forceinline__ void moba_unit(int b, int h, int j, const bf16_t* Q, const bf16_t* K, const bf16_t* VT, bf16_t* O, const float* biasd, const float* kmean, ALAS unsigned char* lds) {
    int tid_ = threadIdx.x; asm volatile("" : "+v"(tid_));
    const int tid = tid_, lane = tid & 63, wid = __builtin_amdgcn_readfirstlane(tid >> 6), r32 = lane & 31, hi = lane >> 5;
    const int q0 = 256 * j + 32 * wid, qpos = q0 + r32;
    if (wid >= 4) __builtin_amdgcn_s_setprio(1);
    const size_t tok0 = (size_t)b * SEQ;
    ALAS float* bt = (ALAS float*)(lds + 36864);
    if (tid < 256) bt[tid] = biasd[h * 256 + tid];
    const float cb = biasd[h * 256 + 255];
    { const int n = tid >> 5, d2 = (tid & 31) * 2; const float* kmp = kmean + (size_t)(b * 16 + n) * 2048 + h * 64 + d2; const float v0 = kmp[0] + kmp[1024], v1 = kmp[1] + kmp[1025];
      const unsigned wh = cvtpk(v0, v1); const float h0 = __uint_as_float(wh << 16), h1 = __uint_as_float(wh & 0xffff0000u); const unsigned wl = cvtpk(v0 - h0, v1 - h1);
      *(ALAS unsigned*)(lds + 37888 + n * ROWB + d2 * 2) = wh; *(ALAS unsigned*)(lds + 40192 + n * ROWB + d2 * 2) = wl; }
    bf16x8 qf[4];
    { const bf16_t* qp = Q + (tok0 + qpos) * 1024 + h * 64 + hi * 8;
#pragma unroll
      for (int d0 = 0; d0 < 4; ++d0) qf[d0] = *(const bf16x8*)(qp + d0 * 16); }
    const int NT = 4 * (j + 1);
    const int key = tid >> 3, part = tid & 7;
    const bf16_t* kg = K + (tok0 + key) * 1024 + h * 64 + part * 8; const int kl = key * ROWB + part * 16;
    const bf16_t* vg = VT + (size_t)(h * 64 + key) * MTOK + tok0 + part * 8; const int vl = 9216 + key * ROWB + part * 16;
    u32x4 kr, vr;
    { const int kb0 = 256 * j; kr = *(const u32x4*)(kg + (size_t)kb0 * 1024); vr = *(const u32x4*)(vg + kb0); }
    __syncthreads();
    unsigned selmask = 0u;
    {
        f32x16 g;
#pragma unroll
        for (int r = 0; r < 16; ++r) g[r] = 0.f;
        const ALAS unsigned char* kp = lds + 37888 + (r32 & 15) * ROWB + hi * 16;
#pragma unroll
        for (int d0 = 0; d0 < 4; ++d0) {
            const bf16x8 ah = *(const ALAS bf16x8*)(kp + d0 * 32), al = *(const ALAS bf16x8*)(kp + 2304 + d0 * 32);
            g = __builtin_amdgcn_mfma_f32_32x32x16_bf16(ah, qf[d0], g, 0, 0, 0);
            g = __builtin_amdgcn_mfma_f32_32x32x16_bf16(al, qf[d0], g, 0, 0, 0);
        }
        float gv[16];
#pragma unroll
        for (int r = 0; r < 8; ++r) { const float own = g[r], oth = __shfl_xor(own, 32); const int n0 = (r & 3) + 8 * (r >> 2);
            gv[n0] = hi ? oth : own; gv[n0 + 4] = hi ? own : oth; }
#pragma unroll
        for (int n = 0; n < 16; ++n) gv[n] = (n < j) ? gv[n] : -INFINITY;
#pragma unroll
        for (int n = 0; n < 16; ++n) { int rank = 0;
#pragma unroll
            for (int m = 0; m < 16; ++m) { if (m == n) continue; rank += (gv[m] > gv[n] || (gv[m] == gv[n] && m < n)) ? 1 : 0; }
#ifdef MOBA_DBG_FIXEDSEL
            rank = ((n + qpos) & 3) ? 99 : 0;
#endif
            if (n < j && rank < MOBA_DBG_TOPK) selmask |= (1u << n); }
    }
    f32x16 o[2]; float mref = 0.f, lsum = 0.f;
#pragma unroll
    for (int d = 0; d < 2; ++d)
#pragma unroll
        for (int r = 0; r < 16; ++r) o[d][r] = 0.f;
    for (int t = 0; t < NT; ++t) {
        ALAS unsigned char* buf = lds + (t & 1) * 18432;
        *(ALAS u32x4*)(buf + kl) = kr; *(ALAS u32x4*)(buf + vl) = vr;
        __syncthreads();
        if (t + 1 < NT) { const int t1 = t + 1; const int kb1 = (t1 < 4) ? (256 * j + 64 * t1) : (64 * (t1 - 4));
            kr = *(const u32x4*)(kg + (size_t)kb1 * 1024); vr = *(const u32x4*)(vg + kb1); }
        const bool own = t < 4; const int n = own ? j : ((t - 4) >> 2); const int kbase = own ? (256 * j + 64 * t) : (64 * (t - 4));
        const bool sel = own ? true : (((selmask >> n) & 1u) != 0u);
        const bool active = own ? (64 * t <= 32 * wid + 31) : (__any(sel) != 0);
        if (active) {
            const bool nearb = (q0 - (kbase + 63)) < 128;
            f32x16 s0, s1; const float ci = sel ? ((nearb ? 0.f : cb) - mref) : NEG;
            qk_tile(s0, s1, ci, buf, qf, r32, hi);
            if (nearb) near_bias(s0, s1, bt, qpos, kbase, hi);
            if (t == 0) anchor(s0, s1, mref);
            softmax_pv<2>(s0, s1, mref, lsum, o, buf + 9216, r32, hi);
        }
    }
    lsum += __shfl_xor(lsum, 32);
    const float inv = 1.0f / lsum;
    bf16_t* op = O + (tok0 + qpos) * 1024 + h * 64 + 4 * hi;
#pragma unroll
    for (int d = 0; d < 2; ++d)
#pragma unroll
        for (int a4 = 0; a4 < 4; ++a4) { u32x2 w; w.x = cvtpk(o[d][4 * a4 + 0] * inv, o[d][4 * a4 + 1] * inv); w.y = cvtpk(o[d][4 * a4 + 2] * inv, o[d][4 * a4 + 3] * inv);
            *(u32x2*)(op + d * 32 + 8 * a4) = w; }
    __builtin_amdgcn_s_setprio(0);
    __syncthreads();
}
}

using pg8::bf16_t;
typedef float f32x4 __attribute__((ext_vector_type(4)));
typedef unsigned v4u __attribute__((ext_vector_type(4)));
#define LAS __attribute__((address_space(3)))
constexpr size_t MiB = 1u << 20;
#define XB_TMO      128
#define XB_XCNT(j)  (256  + 64 * (j))
#define XB_XSUB(j)  (1280 + 64 * (j))
#define XB_XGEN(j)  (2304 + 64 * (j))
#define XB_TOP      3328
#define XB_TOPGEN   3392
#define XCD_BAR_WORDS 3456
#define XB_SPIN_CAP (1u << 18)

__device__ __forceinline__ unsigned xb_ld(unsigned* p)              { return __hip_atomic_load(p, __ATOMIC_RELAXED, __HIP_MEMORY_SCOPE_AGENT); }
__device__ __forceinline__ unsigned xb_add(unsigned* p, unsigned v) { return __hip_atomic_fetch_add(p, v, __ATOMIC_RELAXED, __HIP_MEMORY_SCOPE_AGENT); }
__device__ __forceinline__ unsigned xb_xcc_id() { return (unsigned)__builtin_amdgcn_s_getreg((3 << 11) | 20) & 0xFu; }
#define XB_SPIN(cond, bar) do { unsigned _sp = 0; while (cond) { __builtin_amdgcn_s_sleep(1); \
    if ((++_sp & 255u) == 0u) { if (xb_ld(&(bar)[XB_TMO])) break; if (_sp > XB_SPIN_CAP) { atomicAdd(&(bar)[XB_TMO], 1u); break; } } } } while (0)

struct XcdBarrier {
    unsigned* bar; unsigned x;
    volatile LAS unsigned* st;
};

__device__ __forceinline__ XcdBarrier xcd_barrier_post(unsigned* bar, volatile LAS unsigned* st) {
    XcdBarrier b; b.bar = bar; b.x = xb_xcc_id(); b.st = st;
    if (threadIdx.x == 0) (void)xb_add(&bar[XB_XCNT(b.x)], 1u);
    return b;
}
__device__ __forceinline__ void xcd_barrier_complete(unsigned* bar, unsigned x, unsigned& nloc, unsigned& nx) {
    const unsigned G = gridDim.x * gridDim.y * gridDim.z;
    unsigned sum, cnt, mine, sp = 0u;
    for (;;) {
        sum = 0u; cnt = 0u; mine = 0u;
#pragma unroll
        for (unsigned j = 0; j < 16; ++j) { const unsigned c = xb_ld(&bar[XB_XCNT(j)]); sum += c; cnt += (c > 0u) ? 1u : 0u; mine = (j == x) ? c : mine; }
        if (sum == G) break;
        __builtin_amdgcn_s_sleep(1);
        if ((++sp & 255u) == 0u) { if (xb_ld(&bar[XB_TMO])) break; if (sp > XB_SPIN_CAP) { atomicAdd(&bar[XB_TMO], 1u); break; } }
    }
    nloc = mine > 0u ? mine : 1u; nx = cnt > 0u ? cnt : 1u;
}

__device__ __forceinline__ void xcd_barrier(const XcdBarrier& b) {
    asm volatile("s_waitcnt vmcnt(0)" ::: "memory");
    __syncthreads();
    if (threadIdx.x == 0) {
        unsigned* bar = b.bar;
        __builtin_amdgcn_s_waitcnt(0);
        unsigned nloc = b.st[0], nx = b.st[1];
        if (nloc == 0u) { xcd_barrier_complete(bar, b.x, nloc, nx); b.st[0] = nloc; b.st[1] = nx; }
        const unsigned old = xb_add(&bar[XB_XSUB(b.x)], 1u);
        const unsigned gen = old / nloc;
        if (old + 1u == (gen + 1u) * nloc) {
            __builtin_amdgcn_fence(__ATOMIC_RELEASE, "agent");
            asm volatile("s_waitcnt vmcnt(0)" ::: "memory");
            const unsigned og = xb_add(&bar[XB_TOP], 1u);
            const unsigned tg = og / nx;
            if (og + 1u == (tg + 1u) * nx) xb_add(&bar[XB_TOPGEN], 1u);
            else XB_SPIN(xb_ld(&bar[XB_TOPGEN]) == tg, bar);
            __builtin_amdgcn_fence(__ATOMIC_ACQUIRE, "agent");
            xb_add(&bar[XB_XGEN(b.x)], 1u);
            asm volatile("s_waitcnt vmcnt(0)" ::: "memory");
        } else {
            XB_SPIN(xb_ld(&bar[XB_XGEN(b.x)]) == gen, bar);
            __builtin_amdgcn_fence(__ATOMIC_ACQUIRE, "agent");
            asm volatile("s_waitcnt vmcnt(0)" ::: "memory");
        }
    }
    __syncthreads();
}

constexpr size_t WS_SS = 406 * MiB;
constexpr size_t WS_CTL = 0;
constexpr size_t WS_KMEAN = 1 * MiB;
constexpr size_t WS_BIASD = 2 * MiB;
constexpr size_t WS_WIN = 4 * MiB;
constexpr size_t WS_WOUT = 48 * MiB;
constexpr size_t WS_WQKV = 70 * MiB;
constexpr size_t WS_WO = 82 * MiB;
constexpr size_t WS_XA = 86 * MiB;
constexpr size_t WS_Q = 150 * MiB, WS_K = 214 * MiB, WS_VT = 278 * MiB, WS_O = 342 * MiB;
constexpr size_t WS_ACT = 150 * MiB;
constexpr size_t WS_END = 420 * MiB;
constexpr int LDS_BYTES = 135168;
constexpr int N_PHASES = 16;

struct Params {
    const float *x, *rel_bias, *norm_g, *final_g, *w_in, *w_out, *dq_w, *d_lam, *d_subg, *d_wo, *mq_w, *m_wo;
    float* out; unsigned char* ws; long long ph_lo, ph_hi;
};

__device__ __forceinline__ float wave_sum(float v) {
#pragma unroll
    for (int o = 1; o < 64; o <<= 1) v += __shfl_xor(v, o);
    return v;
}
__device__ __forceinline__ unsigned pk2(float lo, float hi) { return pg8::cvt_pk_bf16(lo, hi); }

__device__ __forceinline__ void xpose_item(const float* W, int K, int N, bf16_t* WT, int k0, int n0, int drow0, const float* g, float cs, LAS float* scr, int lane) {
    float wv[32], gv[32];
#pragma unroll
    for (int i = 0; i < 32; ++i) { const int kk = 2 * i + (lane >> 5); wv[i] = W[(size_t)(k0 + kk) * N + n0 + (lane & 31)]; gv[i] = g ? g[k0 + kk] * cs : cs; }
#pragma unroll
    for (int i = 0; i < 32; ++i) { const int kk = 2 * i + (lane >> 5); scr[kk * 33 + (lane & 31)] = wv[i] * gv[i]; }
    asm volatile("s_waitcnt lgkmcnt(0)" ::: "memory");
    const int c = lane & 7;
#pragma unroll
    for (int jj = 0; jj < 4; ++jj) { const int n = (lane >> 3) + 8 * jj; const LAS float* s = scr + (8 * c) * 33 + n;
        v4u o; o.x = pk2(s[0 * 33], s[1 * 33]); o.y = pk2(s[2 * 33], s[3 * 33]); o.z = pk2(s[4 * 33], s[5 * 33]); o.w = pk2(s[6 * 33], s[7 * 33]);
        *(v4u*)(WT + (size_t)(drow0 + n) * K + k0 + 8 * c) = o; }
    asm volatile("s_waitcnt lgkmcnt(0)" ::: "memory");
}

__device__ __forceinline__ void prologue(const Params& p, LAS unsigned char* lds) {
    int tid_ = threadIdx.x; asm volatile("" : "+v"(tid_));
    const int tid = tid_, lane = tid & 63, wave = __builtin_amdgcn_readfirstlane(tid >> 6);
    const int gw = blockIdx.x * 8 + wave, NGW = gridDim.x * 8;
    unsigned char* ws = p.ws;
    LAS float* scr = (LAS float*)(lds + wave * 16384);
    constexpr int I_IN = 16 * 176, I_OUT = 44 * 32, I_QKV = 16 * 96, I_WO = 16 * 32;
    constexpr int NITEMS = 4 * I_IN + 4 * I_OUT + 2 * I_QKV + 2 * I_WO;
    for (int it = gw; it < NITEMS; it += NGW) {
        int r = it;
        if (r < 4 * I_IN) { const int mi = r / I_IN, item = r % I_IN, kb = item / 176, nb = item % 176, n0 = nb * 32; const int l = mi >> 1, s = mi & 1;
            const int isup = n0 >= FF ? 1 : 0, f = n0 - isup * FF, drow0 = 256 * (f >> 7) + 128 * isup + (f & 127);
            xpose_item(p.w_in + (size_t)mi * 1024 * FF2, 1024, FF2, (bf16_t*)(ws + WS_WIN) + (size_t)mi * FF2 * 1024, kb * 64, n0, drow0, p.norm_g + (l * 3 + (s ? 2 : 0)) * 1024, 1.0f, scr, lane); continue; }
        r -= 4 * I_IN;
        if (r < 4 * I_OUT) { const int mi = r / I_OUT, item = r % I_OUT, kb = item / 32, nb = item % 32;
            xpose_item(p.w_out + (size_t)mi * FF * 1024, FF, 1024, (bf16_t*)(ws + WS_WOUT) + (size_t)mi * 1024 * FF, kb * 64, nb * 32, nb * 32, nullptr, 1.0f, scr, lane); continue; }
        r -= 4 * I_OUT;
        if (r < 2 * I_QKV) { const int l = r / I_QKV, item = r % I_QKV, kb = item / 96, nb = item % 96, n0 = nb * 32;
            xpose_item(l ? p.mq_w : p.dq_w, 1024, 3072, (bf16_t*)(ws + WS_WQKV) + (size_t)l * 3072 * 1024, kb * 64, n0, n0, p.norm_g + (l * 3 + 1) * 1024, n0 < 1024 ? QSCALE : 1.0f, scr, lane); continue; }
        r -= 2 * I_QKV;
        { const int l = r / I_WO, item = r % I_WO, kb = item / 32, nb = item % 32;
            xpose_item(l ? p.m_wo : p.d_wo, 1024, 1024, (bf16_t*)(ws + WS_WO) + (size_t)l * 1024 * 1024, kb * 64, nb * 32, nb * 32, nullptr, 1.0f, scr, lane); }
    }
    float* ss = (float*)(ws + WS_SS);
    for (int m0 = gw; m0 < MTOK; m0 += 2 * NGW) {
        f32x4 v[2][4];
#pragma unroll
        for (int rr = 0; rr < 2; ++rr) { const int m = m0 + rr * NGW; if (m < MTOK) { const f32x4* xr = (const f32x4*)(p.x + (size_t)m * 1024) + lane;
#pragma unroll
            for (int jj = 0; jj < 4; ++jj) v[rr][jj] = xr[64 * jj]; } }
#pragma unroll
        for (int rr = 0; rr < 2; ++rr) { const int m = m0 + rr * NGW; if (m < MTOK) { unsigned long long* o8 = (unsigned long long*)((bf16_t*)(ws + WS_XA) + (size_t)m * 1024) + lane; float s = 0.f;
#pragma unroll
            for (int jj = 0; jj < 4; ++jj) { const f32x4 w = v[rr][jj]; s += (w[0] * w[0] + w[1] * w[1]) + (w[2] * w[2] + w[3] * w[3]);
                o8[64 * jj] = (unsigned long long)pk2(w[0], w[1]) | ((unsigned long long)pk2(w[2], w[3]) << 32); }
            s = wave_sum(s);
            if (lane < 16) ss[(size_t)m * 16 + lane] = lane == 0 ? s : 0.f; } }
    }
    const int gt = blockIdx.x * 512 + tid, NGT = gridDim.x * 512;
    float* bd = (float*)(ws + WS_BIASD);
    for (int i = gt; i < 16 * 256; i += NGT) { const int m = i >> 8, d = i & 255; int bk;
        if (d < 16) bk = d; else { bk = 16 + (int)(logf((float)d / 16.0f) / logf(8.0f) * 16.0f); bk = bk > 31 ? 31 : bk; }
        bd[i] = p.rel_bias[bk * 16 + m] * LOG2E; }
}

__device__ __forceinline__ void final_norm(const Params& p) {
    int tid_ = threadIdx.x; asm volatile("" : "+v"(tid_));
    const int tid = tid_, lane = tid & 63, wave = tid >> 6; const int gw = blockIdx.x * 8 + wave, NGW = gridDim.x * 8;
    const float* ss = (const float*)(p.ws + WS_SS) + (size_t)6 * MTOK * 16;
    const bf16_t* XA = (const bf16_t*)(p.ws + WS_XA);
    f32x4 g[2][2];
#pragma unroll
    for (int jj = 0; jj < 2; ++jj) { g[jj][0] = *(const f32x4*)(p.final_g + 512 * jj + 8 * lane); g[jj][1] = *(const f32x4*)(p.final_g + 512 * jj + 8 * lane + 4); }
    for (int m0 = gw; m0 < MTOK; m0 += 2 * NGW) {
        v4u v[2][2]; f32x4 sp[2];
#pragma unroll
        for (int rr = 0; rr < 2; ++rr) { const int m = m0 + rr * NGW; if (m < MTOK) { const bf16_t* xr = XA + (size_t)m * 1024 + 8 * lane; sp[rr] = *(const f32x4*)(ss + (size_t)m * 16 + 4 * (lane & 3));
            v[rr][0] = *(const v4u*)xr; v[rr][1] = *(const v4u*)(xr + 512); } }
#pragma unroll
        for (int rr = 0; rr < 2; ++rr) { const int m = m0 + rr * NGW; if (m < MTOK) { float* orow = p.out + (size_t)m * 1024 + 8 * lane;
            float s4 = (sp[rr][0] + sp[rr][1]) + (sp[rr][2] + sp[rr][3]); s4 += __shfl_xor(s4, 1); s4 += __shfl_xor(s4, 2);
            const float rs = __builtin_amdgcn_rsqf(s4 * (1.0f / 1024.0f) + 1e-6f);
#pragma unroll
            for (int jj = 0; jj < 2; ++jj) { const v4u w = v[rr][jj]; f32x4 a, b;
                a[0] = __uint_as_float(w.x << 16); a[1] = __uint_as_float(w.x & 0xffff0000u); a[2] = __uint_as_float(w.y << 16); a[3] = __uint_as_float(w.y & 0xffff0000u);
                b[0] = __uint_as_float(w.z << 16); b[1] = __uint_as_float(w.z & 0xffff0000u); b[2] = __uint_as_float(w.w << 16); b[3] = __uint_as_float(w.w & 0xffff0000u);
                *(f32x4*)(orow + 512 * jj) = a * rs * g[jj][0]; *(f32x4*)(orow + 512 * jj + 4) = b * rs * g[jj][1]; } } }
    }
}

template <class Epi>
__device__ __forceinline__ void run_gemm(LAS unsigned char* lds, const bf16_t* A, const bf16_t* Bt, int M, int N, int K, const Epi& E) {
    int bx_ = (int)blockIdx.x; asm volatile("" : "+s"(bx_));
    pg8::Gemm g{A, Bt, M, N, K}; pg8::StaticOrder S; S.init(M, N, (int)gridDim.x, bx_);
#if USE_FAST_GEMM
    pg8::gemm_phase<Epi, pg8::StaticOrder, GEMM_ALIGN_EPI, true>(lds, g, S, E);
#else
    pg8::gemm_simple<Epi, pg8::StaticOrder>(g, S, E);
#endif
}

__global__ void __launch_bounds__(512, 2) fwd_kernel(Params p) {
    extern __shared__ __attribute__((aligned(16))) unsigned char lds_raw[];
    LAS unsigned char* lds = (LAS unsigned char*)lds_raw;
    cg::grid_group grid = cg::this_grid();
    unsigned char* ws = p.ws;
    const int lo = (int)p.ph_lo, hi = (int)p.ph_hi;
    float* ss = (float*)(ws + WS_SS);
    bf16_t* XA = (bf16_t*)(ws + WS_XA); bf16_t* ACT = (bf16_t*)(ws + WS_ACT);
    bf16_t* Qb = (bf16_t*)(ws + WS_Q); bf16_t* Kb = (bf16_t*)(ws + WS_K); bf16_t* VTb = (bf16_t*)(ws + WS_VT); bf16_t* Ob = (bf16_t*)(ws + WS_O);
    { volatile LAS unsigned* misc = (volatile LAS unsigned*)(lds + 131072); if (threadIdx.x < 32) misc[threadIdx.x] = 0u; }
    __syncthreads();
    XcdBarrier bar = xcd_barrier_post((unsigned*)(ws + WS_CTL), (volatile LAS unsigned*)(lds + 131072 + 32));
    if (p.ph_lo < 0) grid.sync();
    const int G = gridDim.x; const int vcu = (G % 8 == 0) ? ((int)blockIdx.x % 8) * (G / 8) + (int)blockIdx.x / 8 : (int)blockIdx.x;
#define IN(k) (lo <= (k) && (k) < hi)
#define SEAM(k) do { if (IN(k) && IN((k) + 1)) { xcd_barrier(bar); } } while (0)
    for (int rep = 0; rep < REPEAT_PRO; ++rep)
    if (IN(0)) { prologue(p, lds); __syncthreads(); }
    SEAM(0);
    for (int l = 0; l < 2; ++l) {
        const int pb = 1 + 7 * l;
        const bf16_t* Win0 = (const bf16_t*)(ws + WS_WIN) + (size_t)(2 * l) * FF2 * 1024; const bf16_t* Win1 = Win0 + (size_t)FF2 * 1024;
        const bf16_t* Wout0 = (const bf16_t*)(ws + WS_WOUT) + (size_t)(2 * l) * 1024 * FF; const bf16_t* Wout1 = Wout0 + (size_t)1024 * FF;
        const bf16_t* Wqkv = (const bf16_t*)(ws + WS_WQKV) + (size_t)l * 3072 * 1024; const bf16_t* Wo = (const bf16_t*)(ws + WS_WO) + (size_t)l * 1024 * 1024;
        for (int rep = 0; rep < REPEAT_UP; ++rep)
        if (IN(pb + 0)) { pg8::EpiSwiglu E{ACT, ss + (size_t)(3 * l) * MTOK * 16}; run_gemm(lds, XA, Win0, MTOK, FF2, 1024, E); }
        SEAM(pb + 0);
        if (IN(pb + 1)) { pg8::EpiResid<false> E{nullptr, XA, ss + (size_t)(3 * l + 1) * MTOK * 16, 0.5f}; run_gemm(lds, ACT, Wout0, MTOK, 1024, FF, E); }
        SEAM(pb + 1);
        if (IN(pb + 2)) {
            { pg8::EpiQK E{Qb, Kb, ss + (size_t)(3 * l + 1) * MTOK * 16, l == 1 ? (float*)(ws + WS_KMEAN) : nullptr}; run_gemm(lds, XA, Wqkv, MTOK, 2048, 1024, E); }
            { pg8::EpiVT E{VTb, ss + (size_t)(3 * l + 1) * MTOK * 16}; run_gemm(lds, Wqkv + (size_t)2048 * 1024, XA, 1024, MTOK, 1024, E); }
        }
        SEAM(pb + 2);
        for (int rep = 0; rep < REPEAT_ATTN; ++rep)
        if (IN(pb + 3) && !(SKIP_ATTN_MASK & (1 << l))) {
            const float* biasd = (const float*)(ws + WS_BIASD);
            if (l == 0) {
                int lane = threadIdx.x & 63; asm volatile("" : "+v"(lane)); const float* lp = p.d_lam;
                const float s1 = wave_sum(lp[lane] * lp[64 + lane]), s2 = wave_sum(lp[128 + lane] * lp[192 + lane]);
                const float lam = expf(s1) - expf(s2) + 0.2f;
                for (int U = vcu; U < 2048; U += G) { const int c = U & 255, i = U >> 8, bh = c >> 2, s = c & 3, pr = i >> 1; const int qb = (i & 1) ? (8 * pr + 7 - s) : (8 * pr + s);
                    att::diff_unit(bh >> 3, bh & 7, qb, Qb, Kb, VTb, Ob, biasd, lam, p.d_subg, lds); }
            } else {
                for (int U = vcu; U < 2048; U += G) { const int c = U & 255, i = U >> 8, bh = c >> 1, s = c & 1, pr = i >> 1; const int j = (i & 1) ? (4 * pr + 3 - s) : (4 * pr + s);
                    att::moba_unit(bh >> 4, bh & 15, j, Qb, Kb, VTb, Ob, biasd, (const float*)(ws + WS_KMEAN), lds); }
            }
        }
        SEAM(pb + 3);
        if (IN(pb + 4)) { pg8::EpiResid<false> E{nullptr, XA, ss + (size_t)(3 * l + 2) * MTOK * 16, 1.0f}; run_gemm(lds, Ob, Wo, MTOK, 1024, 1024, E); }
        SEAM(pb + 4);
        if (IN(pb + 5)) { pg8::EpiSwiglu E{ACT, ss + (size_t)(3 * l + 2) * MTOK * 16}; run_gemm(lds, XA, Win1, MTOK, FF2, 1024, E); }
        SEAM(pb + 5);
        if (IN(pb + 6)) { pg8::EpiResid<false> E{nullptr, XA, ss + (size_t)(3 * l + 3) * MTOK * 16, 0.5f}; run_gemm(lds, ACT, Wout1, MTOK, 1024, FF, E); }
        SEAM(pb + 6);
    }
    if (IN(15)) final_norm(p);
#undef IN
#undef SEAM
}

extern "C" void kernel_launch(void* const* d_in, const int* in_sizes, int n_in, void* d_out, int out_size, void* d_ws, size_t ws_size, hipStream_t stream) {
    static int grid = 0;
    if (grid == 0) {
        if (n_in != 12 || in_sizes[0] != MTOK * 1024 || out_size != MTOK * 1024 || ws_size < WS_END) { fprintf(stderr, "kernel_launch: unexpected shapes (n_in %d, in0 %d, out %d, ws %zu); nothing launched\n", n_in, n_in > 0 ? in_sizes[0] : -1, out_size, ws_size); grid = -1; return; }
        int dev = 0, cus = 0, per_cu = 0;
        if (hipGetDevice(&dev) != hipSuccess || hipDeviceGetAttribute(&cus, hipDeviceAttributeMultiprocessorCount, dev) != hipSuccess) { grid = -1; return; }
        if (hipFuncSetAttribute((const void*)fwd_kernel, hipFuncAttributeMaxDynamicSharedMemorySize, LDS_BYTES) != hipSuccess) { fprintf(stderr, "kernel_launch: hipFuncSetAttribute failed\n"); grid = -1; return; }
        if (hipOccupancyMaxActiveBlocksPerMultiprocessor(&per_cu, (const void*)fwd_kernel, 512, LDS_BYTES) != hipSuccess || per_cu < 1) { fprintf(stderr, "kernel_launch: occupancy query gives %d\n", per_cu); per_cu = 1; }
        (void)hipGetLastError();
        grid = cus * 1;
    }
    if (grid < 0) return;
    if (hipMemsetAsync((char*)d_ws + WS_CTL, 0, 65536, stream) != hipSuccess) { fprintf(stderr, "kernel_launch: memset of the barrier words failed\n"); return; }
    Params p{};
    p.x = (const float*)d_in[0]; p.rel_bias = (const float*)d_in[1]; p.norm_g = (const float*)d_in[2]; p.final_g = (const float*)d_in[3];
    p.w_in = (const float*)d_in[4]; p.w_out = (const float*)d_in[5]; p.dq_w = (const float*)d_in[6]; p.d_lam = (const float*)d_in[7];
    p.d_subg = (const float*)d_in[8]; p.d_wo = (const float*)d_in[9]; p.mq_w = (const float*)d_in[10]; p.m_wo = (const float*)d_in[11];
    p.out = (float*)d_out; p.ws = (unsigned char*)d_ws;
#if N_LAUNCH_MODE == 1
    p.ph_lo = 0; p.ph_hi = N_PHASES;
    void* args[] = {&p};
    hipError_t e = hipLaunchCooperativeKernel((const void*)fwd_kernel, dim3(grid), dim3(512), args, LDS_BYTES, stream);
    if (e != hipSuccess) fprintf(stderr, "kernel_launch: cooperative launch failed: %s (grid %d)\n", hipGetErrorString(e), grid);
#else
    for (int ph = 0; ph < N_PHASES; ++ph) { p.ph_lo = ph; p.ph_hi = ph + 1; hipLaunchKernelGGL(fwd_kernel, dim3(grid), dim3(512), LDS_BYTES, stream, p); }
#endif
}
```

```cpp
#include <hip/hip_runtime.h>
#include <hip/hip_cooperative_groups.h>
#include <cstdio>
#include <cstdint>
namespace cg = cooperative_groups;

#ifndef USE_FAST_GEMM
#define USE_FAST_GEMM 1
#endif
#ifndef SKIP_ATTN_MASK
#define SKIP_ATTN_MASK 0
#endif
#ifndef MOBA_LAG
#define MOBA_LAG 1
#endif
#ifndef DIFF_FUSED
#define DIFF_FUSED 0
#endif
#ifndef DIFF_LAG
#define DIFF_LAG 0
#endif
#ifndef GEMM_ALIGN_EPI
#define GEMM_ALIGN_EPI true
#endif
#ifndef REPEAT_ATTN
#define REPEAT_ATTN 1
#endif
#ifndef REPEAT_PRO
#define REPEAT_PRO 1
#endif
#ifndef REPEAT_SEAM
#define REPEAT_SEAM 1
#endif
#ifndef REPEAT_UP
#define REPEAT_UP 1
#endif
#ifndef MOBA_DBG_TOPK
#define MOBA_DBG_TOPK 3
#endif
#ifndef N_LAUNCH_MODE
#define N_LAUNCH_MODE 1
#endif

constexpr int BATCH = 8, SEQ = 4096, DM = 1024, MTOK = BATCH * SEQ, FF = 2816, FF2 = 2 * FF;
constexpr float LOG2E = 1.4426950408889634f;
constexpr float QSCALE = 0.125f * LOG2E;
constexpr float RMS_EPS = 1e-6f, SUBLN_EPS = 1e-5f;

namespace pg8 {
#define PG8_LAS __attribute__((address_space(3)))
typedef unsigned short bf16_t;
typedef short bf16x8 __attribute__((ext_vector_type(8)));
typedef float f32x4 __attribute__((ext_vector_type(4)));
typedef unsigned u32x4 __attribute__((ext_vector_type(4)));
constexpr int BM = 256, BK = 64, HALF = 128, HTB = HALF * BK * 2  , STAGE_BYTES = 8 * HTB, NXCD = 8, WGM = 8;

__host__ __device__ __forceinline__ int lds_byte(int r, int c) { const int st = (r >> 4) * 2 + (c >> 5), rr = r & 15, cc = c & 31, ob = rr * 64 + cc * 2; return st * 1024 + (ob ^ (((ob >> 9) & 1) << 5)); }
__host__ __device__ __forceinline__ void stage_rc(int b, int& R, int& C) { const int st = b / 1024, sb = b % 1024, swz = sb ^ (((sb >> 9) & 1) << 5); R = (st >> 1) * 16 + swz / 64; C = (st & 1) * 32 + (swz % 64) / 2; }
__host__ __device__ __forceinline__ int perm32(int rho) { const int n = rho >> 4, i = rho & 15; return 8 * (i >> 2) + 4 * n + (i & 3); }

struct Unit { int pm, pn; };
struct Gemm { const bf16_t* A; const bf16_t* Bt; int M, N, K; };

struct StaticOrder {
    int nM, nN, nwg, G, c;
    __host__ __device__ void init(int M, int N, int G_, int c_) { nM = M / BM; nN = N / BM; nwg = nM * nN; G = G_; c = c_; }
    __host__ __device__ bool next(int i, Unit& u) const {
        const long L = (long)i * G + c; if (L >= nwg) return false;
        int wgid = (int)L; { const int q = nwg / NXCD, r = nwg % NXCD, xcd = wgid % NXCD, off = wgid / NXCD; wgid = (xcd < r ? xcd * (q + 1) : r * (q + 1) + (xcd - r) * q) + off; }
        const int nig = WGM * nN, gid = wgid / nig, fm = gid * WGM, gsz = (nM - fm) < WGM ? (nM - fm) : WGM;
        u.pm = fm + ((wgid % nig) % gsz); u.pn = (wgid % nig) / gsz; return true;
    }
    __device__ __forceinline__ void a_ready(const Unit&) const {}
    __device__ __forceinline__ void done(const Unit&) const {}
};
typedef unsigned u32x2 __attribute__((ext_vector_type(2)));
typedef float cvt_f32x2 __attribute__((ext_vector_type(2))); typedef __bf16 cvt_bf16x2 __attribute__((ext_vector_type(2)));
__device__ __forceinline__ unsigned cvt_pk_bf16(float lo, float hi) { cvt_f32x2 v = {lo, hi}; cvt_bf16x2 b = __builtin_convertvector(v, cvt_bf16x2); return __builtin_bit_cast(unsigned, b); }
__device__ __forceinline__ u32x2 pack4(f32x4 v) { u32x2 w; w.x = cvt_pk_bf16(v[0], v[1]); w.y = cvt_pk_bf16(v[2], v[3]); return w; }
__device__ __forceinline__ float rstd_of(const float* ssrow) { const f32x4* q = (const f32x4*)ssrow; const f32x4 a = q[0], b = q[1], c = q[2], d = q[3];
    const float ss = ((a[0] + a[1]) + (a[2] + a[3])) + ((b[0] + b[1]) + (b[2] + b[3])) + (((c[0] + c[1]) + (c[2] + c[3])) + ((d[0] + d[1]) + (d[2] + d[3])));
    const float r = __builtin_amdgcn_rsqf(ss * (1.0f / 1024.0f) + 1e-6f); asm volatile("" ::: "memory"); return r; }

__device__ __forceinline__ float rstd_row4(const float* ssrow, int fq) { const f32x4 a = *(const f32x4*)(ssrow + 4 * fq); float ss = (a[0] + a[1]) + (a[2] + a[3]);
    ss += __shfl_xor(ss, 16); ss += __shfl_xor(ss, 32); return __builtin_amdgcn_rsqf(ss * (1.0f / 1024.0f) + 1e-6f); }
struct EpiSwiglu {
    static constexpr bool PERM = true, AFTER_DRAIN = false;
    bf16_t* out; const float* ss;
    __device__ __forceinline__ void operator()(const f32x4 (&acc)[2][2][4][2], const Unit& u, int wr, int wc, int fr, int fq) const {
#pragma unroll
        for (int ai = 0; ai < 2; ++ai)
#pragma unroll
            for (int m = 0; m < 4; ++m) {
                const int row = u.pm * BM + ai * HALF + wr * 64 + m * 16 + fr; const float rs = rstd_row4(ss + (size_t)row * 16, fq);
                bf16_t* rowp = out + (size_t)row * 2816 + u.pn * 128 + wc * 32 + fq * 8;
                u32x4 w;
                const float rsl = rs * (-1.4426950408889634f), rs2 = rs * rs;
#pragma unroll
                for (int n = 0; n < 2; ++n) {
                    const f32x4 ta = acc[ai][0][m][n] * rsl, gu = acc[ai][0][m][n] * acc[ai][1][m][n]; f32x4 t;
                    t[0] = __builtin_amdgcn_exp2f(ta[0]); t[1] = __builtin_amdgcn_exp2f(ta[1]); t[2] = __builtin_amdgcn_exp2f(ta[2]); t[3] = __builtin_amdgcn_exp2f(ta[3]);
                    const f32x4 dn = t + 1.0f; f32x4 r;
                    r[0] = __builtin_amdgcn_rcpf(dn[0]); r[1] = __builtin_amdgcn_rcpf(dn[1]); r[2] = __builtin_amdgcn_rcpf(dn[2]); r[3] = __builtin_amdgcn_rcpf(dn[3]);
                    const f32x4 h = gu * (r * rs2);
                    const u32x2 pk = pack4(h); if (n == 0) { w.x = pk.x; w.y = pk.y; } else { w.z = pk.x; w.w = pk.y; } }
                *(u32x4*)rowp = w;
            }
    }
};
template <bool F32IN>
struct EpiResid {
    static constexpr bool PERM = true, AFTER_DRAIN = false;
    const float* hin; bf16_t* xa; float* ssout; float alpha;
    __device__ __forceinline__ size_t goff(const Unit& u, int g, int wr, int wc, int fr, int fq) const { return (size_t)(u.pm * BM + (g >> 2) * HALF + wr * 64 + (g & 3) * 16 + fr) * 1024 + u.pn * BM + wc * 32 + fq * 8; }
    struct Grp { f32x4 f[4]; };
    __device__ __forceinline__ void gload(Grp& h, size_t off) const {
        if constexpr (F32IN) { h.f[0] = *(const f32x4*)(hin + off); h.f[1] = *(const f32x4*)(hin + off + 4); h.f[2] = *(const f32x4*)(hin + off + HALF); h.f[3] = *(const f32x4*)(hin + off + HALF + 4); }
        else { const u32x4 a = *(const u32x4*)(xa + off), b = *(const u32x4*)(xa + off + HALF); h.f[0] = __builtin_bit_cast(f32x4, a); h.f[2] = __builtin_bit_cast(f32x4, b); }
    }
    __device__ __forceinline__ void unpack(const Grp& h, int bj, f32x4& v0, f32x4& v1) const {
        if constexpr (F32IN) { v0 = h.f[2 * bj]; v1 = h.f[2 * bj + 1]; }
        else { const u32x4 w = __builtin_bit_cast(u32x4, h.f[2 * bj]);
            v0[0] = __uint_as_float(w.x << 16); v0[1] = __uint_as_float(w.x & 0xffff0000u); v0[2] = __uint_as_float(w.y << 16); v0[3] = __uint_as_float(w.y & 0xffff0000u);
            v1[0] = __uint_as_float(w.z << 16); v1[1] = __uint_as_float(w.z & 0xffff0000u); v1[2] = __uint_as_float(w.w << 16); v1[3] = __uint_as_float(w.w & 0xffff0000u); }
    }
    __device__ __forceinline__ void operator()(const f32x4 (&acc)[2][2][4][2], const Unit& u, int wr, int wc, int fr, int fq) const {
        Grp h[2];
        gload(h[0], goff(u, 0, wr, wc, fr, fq));
#pragma unroll
        for (int g = 0; g < 8; ++g) {
            const int ai = g >> 2, m = g & 3; const size_t off = goff(u, g, wr, wc, fr, fq);
            if (g < 7) gload(h[(g + 1) & 1], goff(u, g + 1, wr, wc, fr, fq));
            float sq = 0.f;
#pragma unroll
            for (int bj = 0; bj < 2; ++bj) { const size_t o = off + bj * HALF; f32x4 h0, h1; unpack(h[g & 1], bj, h0, h1);
                h0 = h0 + acc[ai][bj][m][0] * alpha; h1 = h1 + acc[ai][bj][m][1] * alpha;
                const u32x2 p0 = pack4(h0), p1 = pack4(h1); u32x4 w; w.x = p0.x; w.y = p0.y; w.z = p1.x; w.w = p1.y; *(u32x4*)(xa + o) = w;
                sq += ((h0[0] * h0[0] + h0[1] * h0[1]) + (h0[2] * h0[2] + h0[3] * h0[3])) + ((h1[0] * h1[0] + h1[1] * h1[1]) + (h1[2] * h1[2] + h1[3] * h1[3])); }
            sq += __shfl_xor(sq, 16); sq += __shfl_xor(sq, 32);
            if (fq == 0) ssout[(size_t)(u.pm * BM + ai * HALF + wr * 64 + m * 16 + fr) * 16 + u.pn * 4 + wc] = sq;
            asm volatile("" ::: "memory");
        }
    }
};
struct EpiQK {
    static constexpr bool PERM = true, AFTER_DRAIN = false;
    bf16_t* Qo; bf16_t* Ko; const float* ss; float* kmean;
    __device__ __forceinline__ void operator()(const f32x4 (&acc)[2][2][4][2], const Unit& u, int wr, int wc, int fr, int fq) const {
        const int colt = u.pn * BM; bf16_t* base = colt < 1024 ? Qo : Ko; const int cc = (colt & 1023) + wc * 32 + fq * 8;
        const bool km = (kmean != nullptr) && colt >= 1024;
        f32x4 cs[2][2];
#pragma unroll
        for (int bj = 0; bj < 2; ++bj)
#pragma unroll
            for (int n = 0; n < 2; ++n) cs[bj][n] = (f32x4){0.f, 0.f, 0.f, 0.f};
#pragma unroll
        for (int ai = 0; ai < 2; ++ai)
#pragma unroll
            for (int m = 0; m < 4; ++m) {
                const int row = u.pm * BM + ai * HALF + wr * 64 + m * 16 + fr; const float rs = rstd_row4(ss + (size_t)row * 16, fq);
                bf16_t* rowp = base + (size_t)row * 1024 + cc;
#pragma unroll
                for (int bj = 0; bj < 2; ++bj) { const f32x4 v0 = acc[ai][bj][m][0] * rs, v1 = acc[ai][bj][m][1] * rs; const u32x2 p0 = pack4(v0), p1 = pack4(v1);
                    u32x4 w; w.x = p0.x; w.y = p0.y; w.z = p1.x; w.w = p1.y; *(u32x4*)(rowp + bj * HALF) = w; cs[bj][0] = cs[bj][0] + v0; cs[bj][1] = cs[bj][1] + v1; }
            }
        if (km) {
#pragma unroll
            for (int bj = 0; bj < 2; ++bj)
#pragma unroll
                for (int n = 0; n < 2; ++n)
#pragma unroll
                    for (int i = 0; i < 4; ++i) { float v = cs[bj][n][i]; v += __shfl_xor(v, 1); v += __shfl_xor(v, 2); v += __shfl_xor(v, 4); v += __shfl_xor(v, 8);
                        if (fr == 0) kmean[(size_t)(u.pm * 2 + wr) * 1024 + cc + bj * HALF + n * 4 + i] = v; }
        }
    }
};
struct EpiVT {
    static constexpr bool PERM = false, AFTER_DRAIN = false;
    bf16_t* VT; const float* ss;
    __device__ __forceinline__ void operator()(const f32x4 (&acc)[2][2][4][2], const Unit& u, int wr, int wc, int fr, int fq) const {
#pragma unroll
        for (int bj = 0; bj < 2; ++bj)
#pragma unroll
            for (int n = 0; n < 2; ++n) {
                const int tok = u.pn * BM + bj * HALF + wc * 32 + n * 16 + fq * 4; f32x4 rs; rs[0] = rstd_of(ss + (size_t)tok * 16); rs[1] = rstd_of(ss + (size_t)tok * 16 + 16); rs[2] = rstd_of(ss + (size_t)tok * 16 + 32); rs[3] = rstd_of(ss + (size_t)tok * 16 + 48);
#pragma unroll
                for (int ai = 0; ai < 2; ++ai)
#pragma unroll
                    for (int m = 0; m < 4; ++m) { const int c = u.pm * BM + ai * HALF + wr * 64 + m * 16 + fr; *(u32x2*)(VT + (size_t)c * 32768 + tok) = pack4(acc[ai][bj][m][n] * rs); }
            }
    }
};

template <class Epi, class Sched>
__device__ __forceinline__ void gemm_simple(const Gemm g, const Sched& S, const Epi& E) {
    static_assert(!Epi::PERM, "gemm_simple stages no permuted weight rows");
    int tid_ = threadIdx.x; asm volatile("" : "+v"(tid_));
    const int tid = tid_, wid = __builtin_amdgcn_readfirstlane(tid >> 6), lane = tid & 63, wr = wid >> 2, wc = wid & 3, fr = lane & 15, fq = lane >> 4;
    const int K = g.K; Unit u;
    for (int ui = 0; S.next(ui, u); ++ui) {
        f32x4 acc[2][2][4][2];
#pragma unroll
        for (int a = 0; a < 2; ++a)
#pragma unroll
            for (int b = 0; b < 2; ++b)
#pragma unroll
                for (int m = 0; m < 4; ++m)
#pragma unroll
                    for (int n = 0; n < 2; ++n) acc[a][b][m][n] = (f32x4){0.f, 0.f, 0.f, 0.f};
        const bf16_t* Ab = g.A + (size_t)(u.pm * BM + wr * 64 + fr) * K + fq * 8;
        const bf16_t* Bb = g.Bt + (size_t)(u.pn * BM + wc * 32 + fr) * K + fq * 8;
        for (int k0 = 0; k0 < K; k0 += 32) {
            bf16x8 af[2][4], bfr[2][2];
#pragma unroll
            for (int ai = 0; ai < 2; ++ai)
#pragma unroll
                for (int m = 0; m < 4; ++m) af[ai][m] = *(const bf16x8*)(Ab + (size_t)(ai * HALF + m * 16) * K + k0);
#pragma unroll
            for (int bj = 0; bj < 2; ++bj)
#pragma unroll
                for (int n = 0; n < 2; ++n) bfr[bj][n] = *(const bf16x8*)(Bb + (size_t)(bj * HALF + n * 16) * K + k0);
#pragma unroll
            for (int ai = 0; ai < 2; ++ai)
#pragma unroll
                for (int bj = 0; bj < 2; ++bj)
#pragma unroll
                    for (int m = 0; m < 4; ++m)
#pragma unroll
                        for (int n = 0; n < 2; ++n) acc[ai][bj][m][n] = __builtin_amdgcn_mfma_f32_16x16x32_bf16(bfr[bj][n], af[ai][m], acc[ai][bj][m][n], 0, 0, 0);
        }
        E(acc, u, wr, wc, fr, fq);
    }
}

template <class Epi, class Sched, bool ALIGN_EPI = false, bool SP2 = false>
__device__ __forceinline__ void gemm_phase(PG8_LAS unsigned char* lds, const Gemm g, const Sched& S, const Epi& E) {
    int tid_ = threadIdx.x; asm volatile("" : "+v"(tid_));
    const int tid = tid_, wid = __builtin_amdgcn_readfirstlane(tid >> 6), lane = tid & 63, wr = wid >> 2, wc = wid & 3, fr = lane & 15, fq = lane >> 4;
    const int K = g.K, nt = K / BK;
    unsigned voffA[2], voffB[2];
#pragma unroll
    for (int i = 0; i < 2; ++i) { int R, C; stage_rc(tid * 16 + i * 8192, R, C); const int Rb = Epi::PERM ? ((R & ~31) + perm32(R & 31)) : R;
        voffA[i] = (unsigned)(R * K + C) * 2u; voffB[i] = (unsigned)(Rb * K + C) * 2u; }
    const size_t kstep = (size_t)(BK * 2);
    const size_t hstep = (size_t)HALF * K * 2;
    const size_t tstep = 2 * hstep;
    const unsigned ldsw = (unsigned)wid * 1024u;
    const int aoff = lds_byte(wr * 64 + fr, fq * 8), boff = lds_byte(wc * 32 + fr, fq * 8);
#define PG8_SA(b, h) (((b) * 2 + (h)) * HTB)
#define PG8_SB(b, h) ((4 + (b) * 2 + (h)) * HTB)
#define PG8_STAGE(bufoff, gbase, voff) do { _Pragma("unroll") for (int _i = 0; _i < 2; ++_i) \
        __builtin_amdgcn_global_load_lds((const unsigned*)((const char*)(gbase) + (voff)[_i]), (PG8_LAS unsigned*)(lds + (bufoff) + ldsw + _i * 8192), 16, 0, 0); } while (0)
#define PG8_LDA(dst, b, h) do { _Pragma("unroll") for (int m = 0; m < 4; ++m) _Pragma("unroll") for (int k = 0; k < 2; ++k) dst[m][k] = *(const PG8_LAS bf16x8*)(lds + PG8_SA(b, h) + aoff + m * 2048 + k * 1024); } while (0)
#define PG8_LDB(dst, b, h) do { _Pragma("unroll") for (int n = 0; n < 2; ++n) _Pragma("unroll") for (int k = 0; k < 2; ++k) dst[n][k] = *(const PG8_LAS bf16x8*)(lds + PG8_SB(b, h) + boff + n * 2048 + k * 1024); } while (0)
#define PG8_MMA(ai, bj, At, Bt) do { __builtin_amdgcn_s_setprio(1); _Pragma("unroll") for (int m = 0; m < 4; ++m) _Pragma("unroll") for (int n = 0; n < 2; ++n) _Pragma("unroll") for (int k = 0; k < 2; ++k) \
        acc[ai][bj][m][n] = __builtin_amdgcn_mfma_f32_16x16x32_bf16(Bt[n][k], At[m][k], acc[ai][bj][m][n], 0, 0, 0); __builtin_amdgcn_s_setprio(0); } while (0)
#define PG8_WAIT_V(n) asm volatile("s_waitcnt vmcnt(" #n ")" ::: "memory")
#define PG8_WAIT_L(n) asm volatile("s_waitcnt lgkmcnt(" #n ")" ::: "memory")
#define PG8_BAR __builtin_amdgcn_s_barrier()
#define PG8_SCHED __builtin_amdgcn_sched_barrier(0)
    Unit cur, nxt; int ui = 0;
    if (!S.next(0, cur)) return;
    f32x4 acc[2][2][4][2];
#pragma unroll
    for (int a = 0; a < 2; ++a)
#pragma unroll
        for (int b = 0; b < 2; ++b)
#pragma unroll
            for (int m = 0; m < 4; ++m)
#pragma unroll
                for (int n = 0; n < 2; ++n) acc[a][b][m][n] = (f32x4){0.f, 0.f, 0.f, 0.f};
    bf16x8 At[4][2], B0[2][2], B1[2][2];
    const char* cA = (const char*)g.A + (size_t)cur.pm * tstep; const char* cB = (const char*)g.Bt + (size_t)cur.pn * tstep;
    S.a_ready(cur);
    if constexpr (SP2) {
        PG8_STAGE(PG8_SB(0, 0), cB, voffB); PG8_STAGE(PG8_SB(0, 1), cB + hstep, voffB); PG8_STAGE(PG8_SA(0, 0), cA, voffA); PG8_STAGE(PG8_SA(0, 1), cA + hstep, voffA);
        if (wr == 1) PG8_BAR;
        PG8_WAIT_V(2); PG8_BAR;
        PG8_STAGE(PG8_SB(1, 0), cB + kstep, voffB); PG8_STAGE(PG8_SA(1, 0), cA + kstep, voffA); PG8_STAGE(PG8_SB(1, 1), cB + hstep + kstep, voffB);
        PG8_WAIT_V(6); PG8_BAR;
    } else {
        PG8_STAGE(PG8_SB(0, 0), cB, voffB); PG8_STAGE(PG8_SA(0, 0), cA, voffA); PG8_STAGE(PG8_SB(0, 1), cB + hstep, voffB); PG8_STAGE(PG8_SA(0, 1), cA + hstep, voffA);
        if (wr == 1) PG8_BAR;
        PG8_WAIT_V(4); PG8_BAR;
        PG8_STAGE(PG8_SB(1, 0), cB + kstep, voffB); PG8_STAGE(PG8_SA(1, 0), cA + kstep, voffA); PG8_STAGE(PG8_SB(1, 1), cB + hstep + kstep, voffB);
        PG8_WAIT_V(6); PG8_BAR;
    }
    for (;;) {
        const bool has_next = S.next(ui + 1, nxt);
        const char* nA = has_next ? (const char*)g.A + (size_t)nxt.pm * tstep : cA; const char* nB = has_next ? (const char*)g.Bt + (size_t)nxt.pn * tstep : cB;
        for (int t = 0; t < nt; t += 2) {
            const bool last = (t == nt - 2);
            const char* a1 = cA + (size_t)(t + 1) * kstep;
            const char* a2 = last ? nA : cA + (size_t)(t + 2) * kstep; const char* b2 = last ? nB : cB + (size_t)(t + 2) * kstep;
            const char* a3 = a2 + kstep; const char* b3 = b2 + kstep;
            if (last && has_next) S.a_ready(nxt);
            if constexpr (SP2) {
            PG8_LDB(B0, 0, 0); PG8_LDB(B1, 0, 1); PG8_SCHED; PG8_LDA(At, 0, 0); PG8_STAGE(PG8_SA(1, 1), a1 + hstep, voffA);
            PG8_WAIT_V(8); PG8_WAIT_L(0); PG8_BAR; PG8_MMA(0, 0, At, B0); PG8_MMA(0, 1, At, B1); PG8_BAR; PG8_SCHED;
            PG8_LDA(At, 0, 1); PG8_STAGE(PG8_SB(0, 0), b2, voffB); PG8_STAGE(PG8_SB(0, 1), b2 + hstep, voffB); PG8_STAGE(PG8_SA(0, 0), a2, voffA);
            PG8_WAIT_V(8); PG8_WAIT_L(0); PG8_BAR; PG8_MMA(1, 0, At, B0); PG8_MMA(1, 1, At, B1); PG8_BAR; PG8_SCHED;
            PG8_LDB(B0, 1, 0); PG8_LDB(B1, 1, 1); PG8_SCHED; PG8_LDA(At, 1, 0); PG8_STAGE(PG8_SA(0, 1), a2 + hstep, voffA);
            PG8_WAIT_V(8); PG8_WAIT_L(0); PG8_BAR; PG8_MMA(0, 0, At, B0); PG8_MMA(0, 1, At, B1); PG8_BAR; PG8_SCHED;
            PG8_LDA(At, 1, 1); PG8_STAGE(PG8_SB(1, 0), b3, voffB); PG8_STAGE(PG8_SB(1, 1), b3 + hstep, voffB); PG8_STAGE(PG8_SA(1, 0), a3, voffA);
            PG8_WAIT_V(8); PG8_WAIT_L(0); PG8_BAR; PG8_MMA(1, 0, At, B0); PG8_MMA(1, 1, At, B1); PG8_BAR; PG8_SCHED;
            } else {
            PG8_LDB(B0, 0, 0); PG8_SCHED; PG8_LDA(At, 0, 0); PG8_STAGE(PG8_SA(1, 1), a1 + hstep, voffA);
            PG8_WAIT_L(8); PG8_BAR; PG8_WAIT_L(0); PG8_MMA(0, 0, At, B0); PG8_BAR; PG8_SCHED;
            PG8_LDB(B1, 0, 1); PG8_STAGE(PG8_SB(0, 0), b2, voffB);
            PG8_BAR; PG8_WAIT_L(0); PG8_MMA(0, 1, At, B1); PG8_BAR;
            PG8_LDA(At, 0, 1); PG8_STAGE(PG8_SA(0, 0), a2, voffA);
            PG8_BAR; PG8_WAIT_L(0); PG8_MMA(1, 0, At, B0); PG8_BAR; PG8_SCHED;
            PG8_STAGE(PG8_SB(0, 1), b2 + hstep, voffB);
            PG8_WAIT_V(6); PG8_BAR; PG8_MMA(1, 1, At, B1); PG8_BAR;
            PG8_LDB(B0, 1, 0); PG8_SCHED; PG8_LDA(At, 1, 0); PG8_STAGE(PG8_SA(0, 1), a2 + hstep, voffA);
            PG8_WAIT_L(8); PG8_BAR; PG8_WAIT_L(0); PG8_MMA(0, 0, At, B0); PG8_BAR; PG8_SCHED;
            PG8_LDB(B1, 1, 1); PG8_STAGE(PG8_SB(1, 0), b3, voffB);
            PG8_BAR; PG8_WAIT_L(0); PG8_MMA(0, 1, At, B1); PG8_BAR;
            PG8_LDA(At, 1, 1); PG8_STAGE(PG8_SA(1, 0), a3, voffA);
            PG8_BAR; PG8_WAIT_L(0); PG8_MMA(1, 0, At, B0); PG8_BAR; PG8_SCHED;
            PG8_STAGE(PG8_SB(1, 1), b3 + hstep, voffB);
            PG8_WAIT_V(6); PG8_BAR; PG8_MMA(1, 1, At, B1); PG8_BAR;
            }
        }
        if constexpr (ALIGN_EPI) { if (wr == 0) PG8_BAR; }
        if constexpr (!Epi::AFTER_DRAIN) { E(acc, cur, wr, wc, fr, fq); S.done(cur); }
        if (!has_next) break;
#pragma unroll
        for (int a = 0; a < 2; ++a)
#pragma unroll
            for (int b = 0; b < 2; ++b)
#pragma unroll
                for (int m = 0; m < 4; ++m)
#pragma unroll
                    for (int n = 0; n < 2; ++n) acc[a][b][m][n] = (f32x4){0.f, 0.f, 0.f, 0.f};
        cur = nxt; cA = nA; cB = nB; ++ui;
        if constexpr (ALIGN_EPI) { if (wr == 1) PG8_BAR; }
    }
    PG8_WAIT_V(0);
    if constexpr (!ALIGN_EPI) { if (wr == 0) PG8_BAR; }
    PG8_BAR;
    if constexpr (Epi::AFTER_DRAIN) { E.fused(acc, cur, wr, wc, fr, fq, lds, wid, lane); S.done(cur); }
#undef PG8_SA
#undef PG8_SB
#undef PG8_STAGE
#undef PG8_LDA
#undef PG8_LDB
#undef PG8_MMA
#undef PG8_WAIT_V
#undef PG8_WAIT_L
#undef PG8_BAR
#undef PG8_SCHED
}
}
namespace att {
using pg8::bf16_t; using pg8::bf16x8; using pg8::u32x4; using pg8::u32x2;
typedef float f32x16 __attribute__((ext_vector_type(16)));
#define ALAS __attribute__((address_space(3)))
constexpr int ROWB = 144;
constexpr float NEG = -1e30f;
__device__ __forceinline__ int kperm(int i) { return (i & 19) | ((i & 4) << 1) | ((i & 8) >> 1); }
__device__ __forceinline__ int crow(int r, int hi) { return (r & 3) + 8 * (r >> 2) + 4 * hi; }
__device__ __forceinline__ unsigned cvtpk(float lo, float hi) { return pg8::cvt_pk_bf16(lo, hi); }
__device__ __forceinline__ float ex2(float x) { return __builtin_amdgcn_exp2f(x); }

template <int OFF> __device__ __forceinline__ void ldsr(bf16x8& d, unsigned a) { asm volatile("ds_read_b128 %0, %1 offset:%c2" : "=v"(d) : "v"(a), "i"(OFF) : "memory"); }
__device__ __forceinline__ void lds_wait8(bf16x8 (&a)[8]) { asm volatile("s_waitcnt lgkmcnt(0)" : "+v"(a[0]), "+v"(a[1]), "+v"(a[2]), "+v"(a[3]), "+v"(a[4]), "+v"(a[5]), "+v"(a[6]), "+v"(a[7]) :: "memory"); }
__device__ __forceinline__ void lds_wait4(bf16x8 (&a)[4]) { asm volatile("s_waitcnt lgkmcnt(0)" : "+v"(a[0]), "+v"(a[1]), "+v"(a[2]), "+v"(a[3]) :: "memory"); }
__device__ __forceinline__ void qk_tile(f32x16& s0, f32x16& s1, float ci, const ALAS unsigned char* Kb, const bf16x8 (&qf)[4], int r32, int hi) {
    const unsigned p0 = (unsigned)(uintptr_t)(Kb + kperm(r32) * ROWB + hi * 16);
    bf16x8 a[8];
    ldsr<0>(a[0], p0); ldsr<32 * ROWB>(a[1], p0); ldsr<32>(a[2], p0); ldsr<32 * ROWB + 32>(a[3], p0);
    ldsr<64>(a[4], p0); ldsr<32 * ROWB + 64>(a[5], p0); ldsr<96>(a[6], p0); ldsr<32 * ROWB + 96>(a[7], p0);
#pragma unroll
    for (int r = 0; r < 16; ++r) { s0[r] = ci; s1[r] = ci; }
    lds_wait8(a); __builtin_amdgcn_sched_barrier(0);
#pragma unroll
    for (int d0 = 0; d0 < 4; ++d0) {
        s0 = __builtin_amdgcn_mfma_f32_32x32x16_bf16(a[2 * d0], qf[d0], s0, 0, 0, 0);
        s1 = __builtin_amdgcn_mfma_f32_32x32x16_bf16(a[2 * d0 + 1], qf[d0], s1, 0, 0, 0);
    }
}
template <int NDB, int KB>
__device__ __forceinline__ void issue_v(bf16x8 (&v)[2 * NDB], unsigned vp) {
    ldsr<0 * 32 * ROWB + 64 * KB>(v[0], vp); ldsr<1 * 32 * ROWB + 64 * KB>(v[1], vp);
    if constexpr (NDB == 4) { ldsr<2 * 32 * ROWB + 64 * KB>(v[2], vp); ldsr<3 * 32 * ROWB + 64 * KB>(v[3], vp); }
    ldsr<0 * 32 * ROWB + 64 * KB + 32>(v[NDB + 0], vp); ldsr<1 * 32 * ROWB + 64 * KB + 32>(v[NDB + 1], vp);
    if constexpr (NDB == 4) { ldsr<2 * 32 * ROWB + 64 * KB + 32>(v[NDB + 2], vp); ldsr<3 * 32 * ROWB + 64 * KB + 32>(v[NDB + 3], vp); }
}
template <int NDB> __device__ __forceinline__ void wait_v(bf16x8 (&v)[2 * NDB]) { if constexpr (NDB == 4) lds_wait8(v); else lds_wait4(v); }
__device__ __forceinline__ void pack16(const f32x16& s, bf16x8& pf0, bf16x8& pf1) {
    u32x4 w0, w1;
    w0.x = cvtpk(s[0], s[1]); w0.y = cvtpk(s[2], s[3]); w0.z = cvtpk(s[4], s[5]); w0.w = cvtpk(s[6], s[7]);
    w1.x = cvtpk(s[8], s[9]); w1.y = cvtpk(s[10], s[11]); w1.z = cvtpk(s[12], s[13]); w1.w = cvtpk(s[14], s[15]);
    pf0 = __builtin_bit_cast(bf16x8, w0); pf1 = __builtin_bit_cast(bf16x8, w1);
}
__device__ __forceinline__ void near_bias(f32x16& s0, f32x16& s1, const ALAS float* bt, int qpos, int kbase, int hi) {
#pragma unroll
    for (int r = 0; r < 16; ++r) {
        const int d0 = qpos - (kbase + (r & 7) + 8 * hi + 16 * (r >> 3)), d1 = d0 - 32;
        const float b0 = bt[min(max(d0, 0), 255)], b1 = bt[min(max(d1, 0), 255)];
        s0[r] = d0 < 0 ? NEG : s0[r] + b0; s1[r] = d1 < 0 ? NEG : s1[r] + b1;
    }
}
__device__ __forceinline__ void anchor(f32x16& s0, f32x16& s1, float& mref) {
    float ta = __builtin_fmaxf(__builtin_fmaxf(s0[0], s0[1]), s1[0]), tb = __builtin_fmaxf(__builtin_fmaxf(s0[2], s0[3]), s1[1]); ta = __builtin_fmaxf(__builtin_fmaxf(ta, s1[2]), s1[3]);
#pragma unroll
    for (int r = 4; r < 16; r += 4) { ta = __builtin_fmaxf(__builtin_fmaxf(ta, s0[r]), s0[r + 1]); tb = __builtin_fmaxf(__builtin_fmaxf(tb, s0[r + 2]), s0[r + 3]);
        ta = __builtin_fmaxf(__builtin_fmaxf(ta, s1[r]), s1[r + 1]); tb = __builtin_fmaxf(__builtin_fmaxf(tb, s1[r + 2]), s1[r + 3]); }
    float tm = __builtin_fmaxf(ta, tb);
    tm = __builtin_fmaxf(tm, __shfl_xor(tm, 32));
    mref += tm;
#pragma unroll
    for (int r = 0; r < 16; ++r) { s0[r] -= tm; s1[r] -= tm; }
}
template <int NDB>
__device__ __forceinline__ void softmax_pv(f32x16& s0, f32x16& s1, float& mref, float& lsum, f32x16 (&o)[NDB], const ALAS unsigned char* Vb, int r32, int hi) {
    const unsigned vp = (unsigned)(uintptr_t)(Vb + r32 * ROWB + hi * 16);
    bf16x8 va[2 * NDB], vb[2 * NDB];
    issue_v<NDB, 0>(va, vp);
    float ps = 0.f;
#pragma unroll
    for (int r = 0; r < 16; ++r) { s0[r] = ex2(s0[r]); ps += s0[r]; }
    bf16x8 pf0, pf1, pf2, pf3;
    pack16(s0, pf0, pf1);
    wait_v<NDB>(va);
    issue_v<NDB, 1>(vb, vp);
    __builtin_amdgcn_sched_barrier(0);
#pragma unroll
    for (int d = 0; d < NDB; ++d) o[d] = __builtin_amdgcn_mfma_f32_32x32x16_bf16(va[d], pf0, o[d], 0, 0, 0);
#pragma unroll
    for (int d = 0; d < NDB; ++d) o[d] = __builtin_amdgcn_mfma_f32_32x32x16_bf16(va[NDB + d], pf1, o[d], 0, 0, 0);
#pragma unroll
    for (int r = 0; r < 16; ++r) { s1[r] = ex2(s1[r]); ps += s1[r]; }
    pack16(s1, pf2, pf3);
#pragma unroll
    for (int i = 0; i < 2 * NDB; ++i) { __builtin_amdgcn_sched_group_barrier(0x008, 1, 0); __builtin_amdgcn_sched_group_barrier(0x002, (NDB == 4 ? 5 : 10), 0); }
    __builtin_amdgcn_sched_barrier(0);
    wait_v<NDB>(vb);
    __builtin_amdgcn_sched_barrier(0);
#pragma unroll
    for (int d = 0; d < NDB; ++d) o[d] = __builtin_amdgcn_mfma_f32_32x32x16_bf16(vb[d], pf2, o[d], 0, 0, 0);
#pragma unroll
    for (int d = 0; d < NDB; ++d) o[d] = __builtin_amdgcn_mfma_f32_32x32x16_bf16(vb[NDB + d], pf3, o[d], 0, 0, 0);
    lsum += ps;
    if (__any(ps > 1048576.0f)) {
        const float pt = ps + __shfl_xor(ps, 32); const float dl = pt > 1048576.0f ? floorf(__log2f(pt)) : 0.f, al = ex2(-dl); mref += dl; lsum *= al;
#pragma unroll
        for (int d = 0; d < NDB; ++d)
#pragma unroll
            for (int r = 0; r < 16; ++r) o[d][r] *= al;
    }
}

__device__ __forceinline__ void diff_unit(int b, int hd, int qb, const bf16_t* Q, const bf16_t* K, const bf16_t* VT, bf16_t* O, const float* biasd, float lam, const float* subg, ALAS unsigned char* lds) {
    int tid_ = threadIdx.x; asm volatile("" : "+v"(tid_));
    const int tid = tid_, lane = tid & 63, wid = __builtin_amdgcn_readfirstlane(tid >> 6), r32 = lane & 31, hi = lane >> 5;
    const int map = wid >> 2, w4 = wid & 3, q0 = qb * 128 + w4 * 32, qpos = q0 + r32;
    if (wid >= 4) __builtin_amdgcn_s_setprio(1);
    const size_t tok0 = (size_t)b * SEQ;
    ALAS float* btab = (ALAS float*)(lds + 73728);
    btab[tid] = biasd[(2 * hd) * 256 + tid];
    const ALAS float* bt = btab + map * 256;
    const float cb = biasd[(2 * hd + map) * 256 + 255];
    bf16x8 qf[4];
    { const bf16_t* qp = Q + (tok0 + qpos) * 1024 + (2 * hd + map) * 64 + hi * 8;
#pragma unroll
      for (int d0 = 0; d0 < 4; ++d0) qf[d0] = *(const bf16x8*)(qp + d0 * 16); }
    const int NT = 2 * (qb + 1);
    const bf16_t* kg[2]; const bf16_t* vg[2]; int kl[2], vl[2];
#pragma unroll
    for (int i = 0; i < 2; ++i) { const int c = tid + 512 * i; const int key = c >> 4, part = c & 15;
        kg[i] = K + (tok0 + key) * 1024 + hd * 128 + part * 8; kl[i] = ((part >> 3) * 64 + key) * ROWB + (part & 7) * 16;
        const int d = c >> 3, pv = c & 7; vg[i] = VT + (size_t)(hd * 128 + d) * MTOK + tok0 + pv * 8; vl[i] = 18432 + d * ROWB + pv * 16; }
    u32x4 kr[2], vr[2];
#pragma unroll
    for (int i = 0; i < 2; ++i) { kr[i] = *(const u32x4*)(kg[i]); vr[i] = *(const u32x4*)(vg[i]); }
    f32x16 o[4]; float mref = 0.f, lsum = 0.f;
#pragma unroll
    for (int d = 0; d < 4; ++d)
#pragma unroll
        for (int r = 0; r < 16; ++r) o[d][r] = 0.f;
    for (int t = 0; t < NT; ++t) {
        ALAS unsigned char* buf = lds + (t & 1) * 36864;
#pragma unroll
        for (int i = 0; i < 2; ++i) { *(ALAS u32x4*)(buf + kl[i]) = kr[i]; *(ALAS u32x4*)(buf + vl[i]) = vr[i]; }
        __syncthreads();
        if (t + 1 < NT) {
#pragma unroll
            for (int i = 0; i < 2; ++i) { kr[i] = *(const u32x4*)(kg[i] + (size_t)(t + 1) * 64 * 1024); vr[i] = *(const u32x4*)(vg[i] + (t + 1) * 64); }
        }
        const int kbase = 64 * t;
        if (kbase <= q0 + 31) {
            const bool far = (q0 - (kbase + 63)) >= 128;
            f32x16 s0, s1; const float ci = (far ? cb : 0.f) - mref;
            qk_tile(s0, s1, ci, buf + map * 9216, qf, r32, hi);
            if (!far) near_bias(s0, s1, bt, qpos, kbase, hi);
            if (t == 0) anchor(s0, s1, mref);
            softmax_pv<4>(s0, s1, mref, lsum, o, buf + 18432, r32, hi);
        }
    }
    lsum += __shfl_xor(lsum, 32);
    const float inv = 1.0f / lsum;
    __syncthreads();
    ALAS float* X = (ALAS float*)lds;
    if (map == 1) {
#pragma unroll
        for (int d = 0; d < 4; ++d)
#pragma unroll
            for (int r = 0; r < 16; ++r) X[((w4 * 4 + d) * 16 + r) * 64 + lane] = o[d][r] * inv;
    }
    __syncthreads();
    if (map == 0) {
        float sq = 0.f;
#pragma unroll
        for (int d = 0; d < 4; ++d)
#pragma unroll
            for (int r = 0; r < 16; ++r) { const float a = o[d][r] * inv - lam * X[((w4 * 4 + d) * 16 + r) * 64 + lane]; o[d][r] = a; sq += a * a; }
        sq += __shfl_xor(sq, 32);
        const float rn = __builtin_amdgcn_rsqf(sq * (1.0f / 128.0f) + SUBLN_EPS) * 0.8f;
        bf16_t* op = O + (tok0 + qpos) * 1024 + hd * 128 + 4 * hi;
#pragma unroll
        for (int d = 0; d < 4; ++d)
#pragma unroll
            for (int a4 = 0; a4 < 4; ++a4) { const int c0 = d * 32 + 8 * a4; const pg8::f32x4 g4 = *(const pg8::f32x4*)(subg + c0 + 4 * hi); u32x2 w;
                w.x = cvtpk(o[d][4 * a4 + 0] * rn * g4[0], o[d][4 * a4 + 1] * rn * g4[1]); w.y = cvtpk(o[d][4 * a4 + 2] * rn * g4[2], o[d][4 * a4 + 3] * rn * g4[3]);
                *(u32x2*)(op + c0) = w; }
    }
    __builtin_amdgcn_s_setprio(0);
    __syncthreads();
}

__device__ __forceinline__ void moba_unit(int b, int h, int j, const bf16_t* Q, const bf16_t* K, const bf16_t* VT, bf16_t* O, const float* biasd, const float* kmean, ALAS unsigned char* lds) {
    int tid_ = threadIdx.x; asm volatile("" : "+v"(tid_));
    const int tid = tid_, lane = tid & 63, wid = __builtin_amdgcn_readfirstlane(tid >> 6), r32 = lane & 31, hi = lane >> 5;
    const int q0 = 256 * j + 32 * wid, qpos = q0 + r32;
    if (wid >= 4) __builtin_amdgcn_s_setprio(1);
    const size_t tok0 = (size_t)b * SEQ;
    ALAS float* bt = (ALAS float*)(lds + 36864);
    if (tid < 256) bt[tid] = biasd[h * 256 + tid];
    const float cb = biasd[h * 256 + 255];
    { const int n = tid >> 5, d2 = (tid & 31) * 2; const float* kmp = kmean + (size_t)(b * 16 + n) * 2048 + h * 64 + d2; const float v0 = kmp[0] + kmp[1024], v1 = kmp[1] + kmp[1025];
      const unsigned wh = cvtpk(v0, v1); const float h0 = __uint_as_float(wh << 16), h1 = __uint_as_float(wh & 0xffff0000u); const unsigned wl = cvtpk(v0 - h0, v1 - h1);
      *(ALAS unsigned*)(lds + 37888 + n * ROWB + d2 * 2) = wh; *(ALAS unsigned*)(lds + 40192 + n * ROWB + d2 * 2) = wl; }
    bf16x8 qf[4];
    { const bf16_t* qp = Q + (tok0 + qpos) * 1024 + h * 64 + hi * 8;
#pragma unroll
      for (int d0 = 0; d0 < 4; ++d0) qf[d0] = *(const bf16x8*)(qp + d0 * 16); }
    const int NT = 4 * (j + 1);
    const int key = tid >> 3, part = tid & 7;
    const bf16_t* kg = K + (tok0 + key) * 1024 + h * 64 + part * 8; const int kl = key * ROWB + part * 16;
    const bf16_t* vg = VT + (size_t)(h * 64 + key) * MTOK + tok0 + part * 8; const int vl = 9216 + key * ROWB + part * 16;
    u32x4 kr, vr;
    { const int kb0 = 256 * j; kr = *(const u32x4*)(kg + (size_t)kb0 * 1024); vr = *(const u32x4*)(vg + kb0); }
    __syncthreads();
    unsigned selmask = 0u;
    {
        f32x16 g;
#pragma unroll
        for (int r = 0; r < 16; ++r) g[r] = 0.f;
        const ALAS unsigned char* kp = lds + 37888 + (r32 & 15) * ROWB + hi * 16;
#pragma unroll
        for (int d0 = 0; d0 < 4; ++d0) {
            const bf16x8 ah = *(const ALAS bf16x8*)(kp + d0 * 32), al = *(const ALAS bf16x8*)(kp + 2304 + d0 * 32);
            g = __builtin_amdgcn_mfma_f32_32x32x16_bf16(ah, qf[d0], g, 0, 0, 0);
            g = __builtin_amdgcn_mfma_f32_32x32x16_bf16(al, qf[d0], g, 0, 0, 0);
        }
        float gv[16];
#pragma unroll
        for (int r = 0; r < 8; ++r) { const float own = g[r], oth = __shfl_xor(own, 32); const int n0 = (r & 3) + 8 * (r >> 2);
            gv[n0] = hi ? oth : own; gv[n0 + 4] = hi ? own : oth; }
#pragma unroll
        for (int n = 0; n < 16; ++n) gv[n] = (n < j) ? gv[n] : -INFINITY;
#pragma unroll
        for (int n = 0; n < 16; ++n) { int rank = 0;
#pragma unroll
            for (int m = 0; m < 16; ++m) { if (m == n) continue; rank += (gv[m] > gv[n] || (gv[m] == gv[n] && m < n)) ? 1 : 0; }
#ifdef MOBA_DBG_FIXEDSEL
            rank = ((n + qpos) & 3) ? 99 : 0;
#endif
            if (n < j && rank < MOBA_DBG_TOPK) selmask |= (1u << n); }
    }
    f32x16 o[2]; float mref = 0.f, lsum = 0.f;
#pragma unroll
    for (int d = 0; d < 2; ++d)
#pragma unroll
        for (int r = 0; r < 16; ++r) o[d][r] = 0.f;
    for (int t = 0; t < NT; ++t) {
        ALAS unsigned char* buf = lds + (t & 1) * 18432;
        *(ALAS u32x4*)(buf + kl) = kr; *(ALAS u32x4*)(buf + vl) = vr;
        __syncthreads();
        if (t + 1 < NT) { const int t1 = t + 1; const int kb1 = (t1 < 4) ? (256 * j + 64 * t1) : (64 * (t1 - 4));
            kr = *(const u32x4*)(kg + (size_t)kb1 * 1024); vr = *(const u32x4*)(vg + kb1); }
        const bool own = t < 4; const int n = own ? j : ((t - 4) >> 2); const int kbase = own ? (256 * j + 64 * t) : (64 * (t - 4));
        const bool sel = own ? true : (((selmask >> n) & 1u) != 0u);
        const bool active = own ? (64 * t <= 32 * wid + 31) : (__any(sel) != 0);
        if (active) {
            const bool nearb = (q0 - (kbase + 63)) < 128;
            f32x16 s0, s1; const float ci = sel ? ((nearb ? 0.f : cb) - mref) : NEG;
            qk_tile(s0, s1, ci, buf, qf, r32, hi);
            if (nearb) near_bias(s0, s1, bt, qpos, kbase, hi);
            if (t == 0) anchor(s0, s1, mref);
            softmax_pv<2>(s0, s1, mref, lsum, o, buf + 9216, r32, hi);
        }
    }
    lsum += __shfl_xor(lsum, 32);
    const float inv = 1.0f / lsum;
    bf16_t* op = O + (tok0 + qpos) * 1024 + h * 64 + 4 * hi;
#pragma unroll
    for (int d = 0; d < 2; ++d)
#pragma unroll
        for (int a4 = 0; a4 < 4; ++a4) { u32x2 w; w.x = cvtpk(o[d][4 * a4 + 0] * inv, o[d][4 * a4 + 1] * inv); w.y = cvtpk(o[d][4 * a4 + 2] * inv, o[d][4 * a4 + 3] * inv);
            *(u32x2*)(op + d * 32 + 8 * a4) = w; }
    __builtin_amdgcn_s_setprio(0);
    __syncthreads();
}
}

using pg8::bf16_t;
typedef float f32x4 __attribute__((ext_vector_type(4)));
typedef unsigned v4u __attribute__((ext_vector_type(4)));
#define LAS __attribute__((address_space(3)))
constexpr size_t MiB = 1u << 20;
#define XB_TMO      128
#define XB_XCNT(j)  (256  + 64 * (j))
#define XB_XSUB(j)  (1280 + 64 * (j))
#define XB_XGEN(j)  (2304 + 64 * (j))
#define XB_TOP      3328
#define XB_TOPGEN   3392
#define XCD_BAR_WORDS 3456
#define XB_SPIN_CAP (1u << 18)

__device__ __forceinline__ unsigned xb_ld(unsigned* p)              { return __hip_atomic_load(p, __ATOMIC_RELAXED, __HIP_MEMORY_SCOPE_AGENT); }
__device__ __forceinline__ unsigned xb_add(unsigned* p, unsigned v) { return __hip_atomic_fetch_add(p, v, __ATOMIC_RELAXED, __HIP_MEMORY_SCOPE_AGENT); }
__device__ __forceinline__ unsigned xb_xcc_id() { return (unsigned)__builtin_amdgcn_s_getreg((3 << 11) | 20) & 0xFu; }
#define XB_SPIN(cond, bar) do { unsigned _sp = 0; while (cond) { __builtin_amdgcn_s_sleep(1); \
    if ((++_sp & 255u) == 0u) { if (xb_ld(&(bar)[XB_TMO])) break; if (_sp > XB_SPIN_CAP) { atomicAdd(&(bar)[XB_TMO], 1u); break; } } } } while (0)

struct XcdBarrier {
    unsigned* bar; unsigned x;
    volatile LAS unsigned* st;
};

__device__ __forceinline__ XcdBarrier xcd_barrier_post(unsigned* bar, volatile LAS unsigned* st) {
    XcdBarrier b; b.bar = bar; b.x = xb_xcc_id(); b.st = st;
    if (threadIdx.x == 0) (void)xb_add(&bar[XB_XCNT(b.x)], 1u);
    return b;
}
__device__ __forceinline__ void xcd_barrier_complete(unsigned* bar, unsigned x, unsigned& nloc, unsigned& nx) {
    const unsigned G = gridDim.x * gridDim.y * gridDim.z;
    unsigned sum, cnt, mine, sp = 0u;
    for (;;) {
        sum = 0u; cnt = 0u; mine = 0u;
#pragma unroll
        for (unsigned j = 0; j < 16; ++j) { const unsigned c = xb_ld(&bar[XB_XCNT(j)]); sum += c; cnt += (c > 0u) ? 1u : 0u; mine = (j == x) ? c : mine; }
        if (sum == G) break;
        __builtin_amdgcn_s_sleep(1);
        if ((++sp & 255u) == 0u) { if (xb_ld(&bar[XB_TMO])) break; if (sp > XB_SPIN_CAP) { atomicAdd(&bar[XB_TMO], 1u); break; } }
    }
    nloc = mine > 0u ? mine : 1u; nx = cnt > 0u ? cnt : 1u;
}

__device__ __forceinline__ void xcd_barrier(const XcdBarrier& b) {
    asm volatile("s_waitcnt vmcnt(0)" ::: "memory");
    __syncthreads();
    if (threadIdx.x == 0) {
        unsigned* bar = b.bar;
        __builtin_amdgcn_s_waitcnt(0);
        unsigned nloc = b.st[0], nx = b.st[1];
        if (nloc == 0u) { xcd_barrier_complete(bar, b.x, nloc, nx); b.st[0] = nloc; b.st[1] = nx; }
        const unsigned old = xb_add(&bar[XB_XSUB(b.x)], 1u);
        const unsigned gen = old / nloc;
        if (old + 1u == (gen + 1u) * nloc) {
            __builtin_amdgcn_fence(__ATOMIC_RELEASE, "agent");
            asm volatile("s_waitcnt vmcnt(0)" ::: "memory");
            const unsigned og = xb_add(&bar[XB_TOP], 1u);
            const unsigned tg = og / nx;
            if (og + 1u == (tg + 1u) * nx) xb_add(&bar[XB_TOPGEN], 1u);
            else XB_SPIN(xb_ld(&bar[XB_TOPGEN]) == tg, bar);
            __builtin_amdgcn_fence(__ATOMIC_ACQUIRE, "agent");
            xb_add(&bar[XB_XGEN(b.x)], 1u);
            asm volatile("s_waitcnt vmcnt(0)" ::: "memory");
        } else {
            XB_SPIN(xb_ld(&bar[XB_XGEN(b.x)]) == gen, bar);
            __builtin_amdgcn_fence(__ATOMIC_ACQUIRE, "agent");
            asm volatile("s_waitcnt vmcnt(0)" ::: "memory");
        }
    }
    __syncthreads();
}

constexpr size_t WS_SS = 406 * MiB;
constexpr size_t WS_CTL = 0;
constexpr size_t WS_KMEAN = 1 * MiB;
constexpr size_t WS_BIASD = 2 * MiB;
constexpr size_t WS_WIN = 4 * MiB;
constexpr size_t WS_WOUT = 48 * MiB;
constexpr size_t WS_WQKV = 70 * MiB;
constexpr size_t WS_WO = 82 * MiB;
constexpr size_t WS_XA = 86 * MiB;
constexpr size_t WS_Q = 150 * MiB, WS_K = 214 * MiB, WS_VT = 278 * MiB, WS_O = 342 * MiB;
constexpr size_t WS_ACT = 150 * MiB;
constexpr size_t WS_END = 420 * MiB;
constexpr int LDS_BYTES = 135168;
constexpr int N_PHASES = 16;

struct Params {
    const float *x, *rel_bias, *norm_g, *final_g, *w_in, *w_out, *dq_w, *d_lam, *d_subg, *d_wo, *mq_w, *m_wo;
    float* out; unsigned char* ws; long long ph_lo, ph_hi;
};

__device__ __forceinline__ float wave_sum(float v) {
#pragma unroll
    for (int o = 1; o < 64; o <<= 1) v += __shfl_xor(v, o);
    return v;
}
__device__ __forceinline__ unsigned pk2(float lo, float hi) { return pg8::cvt_pk_bf16(lo, hi); }

__device__ __forceinline__ void xpose_item(const float* W, int K, int N, bf16_t* WT, int k0, int n0, int drow0, const float* g, float cs, LAS float* scr, int lane) {
    float wv[32], gv[32];
#pragma unroll
    for (int i = 0; i < 32; ++i) { const int kk = 2 * i + (lane >> 5); wv[i] = __builtin_nontemporal_load(W + (size_t)(k0 + kk) * N + n0 + (lane & 31)); gv[i] = g ? g[k0 + kk] * cs : cs; }
#pragma unroll
    for (int i = 0; i < 32; ++i) { const int kk = 2 * i + (lane >> 5); scr[kk * 33 + (lane & 31)] = wv[i] * gv[i]; }
    asm volatile("s_waitcnt lgkmcnt(0)" ::: "memory");
    const int c = lane & 7;
#pragma unroll
    for (int jj = 0; jj < 4; ++jj) { const int n = (lane >> 3) + 8 * jj; const LAS float* s = scr + (8 * c) * 33 + n;
        v4u o; o.x = pk2(s[0 * 33], s[1 * 33]); o.y = pk2(s[2 * 33], s[3 * 33]); o.z = pk2(s[4 * 33], s[5 * 33]); o.w = pk2(s[6 * 33], s[7 * 33]);
        *(v4u*)(WT + (size_t)(drow0 + n) * K + k0 + 8 * c) = o; }
    asm volatile("s_waitcnt lgkmcnt(0)" ::: "memory");
}

__device__ __forceinline__ void prologue(const Params& p, LAS unsigned char* lds) {
    int tid_ = threadIdx.x; asm volatile("" : "+v"(tid_));
    const int tid = tid_, lane = tid & 63, wave = __builtin_amdgcn_readfirstlane(tid >> 6);
    const int gw = blockIdx.x * 8 + wave, NGW = gridDim.x * 8;
    unsigned char* ws = p.ws;
    LAS float* scr = (LAS float*)(lds + wave * 16384);
    constexpr int I_IN = 16 * 176, I_OUT = 44 * 32, I_QKV = 16 * 96, I_WO = 16 * 32;
    constexpr int NITEMS = 4 * I_IN + 4 * I_OUT + 2 * I_QKV + 2 * I_WO;
    for (int it = gw; it < NITEMS; it += NGW) {
        int r = it;
        if (r < 4 * I_IN) { const int mi = r / I_IN, item = r % I_IN, kb = item / 176, nb = item % 176, n0 = nb * 32; const int l = mi >> 1, s = mi & 1;
            const int isup = n0 >= FF ? 1 : 0, f = n0 - isup * FF, drow0 = 256 * (f >> 7) + 128 * isup + (f & 127);
            xpose_item(p.w_in + (size_t)mi * 1024 * FF2, 1024, FF2, (bf16_t*)(ws + WS_WIN) + (size_t)mi * FF2 * 1024, kb * 64, n0, drow0, p.norm_g + (l * 3 + (s ? 2 : 0)) * 1024, 1.0f, scr, lane); continue; }
        r -= 4 * I_IN;
        if (r < 4 * I_OUT) { const int mi = r / I_OUT, item = r % I_OUT, kb = item / 32, nb = item % 32;
            xpose_item(p.w_out + (size_t)mi * FF * 1024, FF, 1024, (bf16_t*)(ws + WS_WOUT) + (size_t)mi * 1024 * FF, kb * 64, nb * 32, nb * 32, nullptr, 1.0f, scr, lane); continue; }
        r -= 4 * I_OUT;
        if (r < 2 * I_QKV) { const int l = r / I_QKV, item = r % I_QKV, kb = item / 96, nb = item % 96, n0 = nb * 32;
            xpose_item(l ? p.mq_w : p.dq_w, 1024, 3072, (bf16_t*)(ws + WS_WQKV) + (size_t)l * 3072 * 1024, kb * 64, n0, n0, p.norm_g + (l * 3 + 1) * 1024, n0 < 1024 ? QSCALE : 1.0f, scr, lane); continue; }
        r -= 2 * I_QKV;
        { const int l = r / I_WO, item = r % I_WO, kb = item / 32, nb = item % 32;
            xpose_item(l ? p.m_wo : p.d_wo, 1024, 1024, (bf16_t*)(ws + WS_WO) + (size_t)l * 1024 * 1024, kb * 64, nb * 32, nb * 32, nullptr, 1.0f, scr, lane); }
    }
    float* ss = (float*)(ws + WS_SS);
    for (int m0 = gw; m0 < MTOK; m0 += 2 * NGW) {
        f32x4 v[2][4];
#pragma unroll
        for (int rr = 0; rr < 2; ++rr) { const int m = m0 + rr * NGW; if (m < MTOK) { const f32x4* xr = (const f32x4*)(p.x + (size_t)m * 1024) + lane;
#pragma unroll
            for (int jj = 0; jj < 4; ++jj) v[rr][jj] = __builtin_nontemporal_load(xr + 64 * jj); } }
#pragma unroll
        for (int rr = 0; rr < 2; ++rr) { const int m = m0 + rr * NGW; if (m < MTOK) { unsigned long long* o8 = (unsigned long long*)((bf16_t*)(ws + WS_XA) + (size_t)m * 1024) + lane; float s = 0.f;
#pragma unroll
            for (int jj = 0; jj < 4; ++jj) { const f32x4 w = v[rr][jj]; s += (w[0] * w[0] + w[1] * w[1]) + (w[2] * w[2] + w[3] * w[3]);
                o8[64 * jj] = (unsigned long long)pk2(w[0], w[1]) | ((unsigned long long)pk2(w[2], w[3]) << 32); }
            s = wave_sum(s);
            if (lane < 16) ss[(size_t)m * 16 + lane] = lane == 0 ? s : 0.f; } }
    }
    const int gt = blockIdx.x * 512 + tid, NGT = gridDim.x * 512;
    float* bd = (float*)(ws + WS_BIASD);
    for (int i = gt; i < 16 * 256; i += NGT) { const int m = i >> 8, d = i & 255; int bk;
        if (d < 16) bk = d; else { bk = 16 + (int)(logf((float)d / 16.0f) / logf(8.0f) * 16.0f); bk = bk > 31 ? 31 : bk; }
        bd[i] = p.rel_bias[bk * 16 + m] * LOG2E; }
}

__device__ __forceinline__ void final_norm(const Params& p) {
    int tid_ = threadIdx.x; asm volatile("" : "+v"(tid_));
    const int tid = tid_, lane = tid & 63, wave = tid >> 6; const int gw = blockIdx.x * 8 + wave, NGW = gridDim.x * 8;
    const float* ss = (const float*)(p.ws + WS_SS) + (size_t)6 * MTOK * 16;
    const bf16_t* XA = (const bf16_t*)(p.ws + WS_XA);
    f32x4 g[2][2];
#pragma unroll
    for (int jj = 0; jj < 2; ++jj) { g[jj][0] = *(const f32x4*)(p.final_g + 512 * jj + 8 * lane); g[jj][1] = *(const f32x4*)(p.final_g + 512 * jj + 8 * lane + 4); }
    for (int m0 = gw; m0 < MTOK; m0 += 2 * NGW) {
        v4u v[2][2]; f32x4 sp[2];
#pragma unroll
        for (int rr = 0; rr < 2; ++rr) { const int m = m0 + rr * NGW; if (m < MTOK) { const bf16_t* xr = XA + (size_t)m * 1024 + 8 * lane; sp[rr] = *(const f32x4*)(ss + (size_t)m * 16 + 4 * (lane & 3));
            v[rr][0] = *(const v4u*)xr; v[rr][1] = *(const v4u*)(xr + 512); } }
#pragma unroll
        for (int rr = 0; rr < 2; ++rr) { const int m = m0 + rr * NGW; if (m < MTOK) { float* orow = p.out + (size_t)m * 1024 + 8 * lane;
            float s4 = (sp[rr][0] + sp[rr][1]) + (sp[rr][2] + sp[rr][3]); s4 += __shfl_xor(s4, 1); s4 += __shfl_xor(s4, 2);
            const float rs = __builtin_amdgcn_rsqf(s4 * (1.0f / 1024.0f) + 1e-6f);
#pragma unroll
            for (int jj = 0; jj < 2; ++jj) { const v4u w = v[rr][jj]; f32x4 a, b;
                a[0] = __uint_as_float(w.x << 16); a[1] = __uint_as_float(w.x & 0xffff0000u); a[2] = __uint_as_float(w.y << 16); a[3] = __uint_as_float(w.y & 0xffff0000u);
                b[0] = __uint_as_float(w.z << 16); b[1] = __uint_as_float(w.z & 0xffff0000u); b[2] = __uint_as_float(w.w << 16); b[3] = __uint_as_float(w.w & 0xffff0000u);
                *(f32x4*)(orow + 512 * jj) = a * rs * g[jj][0]; *(f32x4*)(orow + 512 * jj + 4) = b * rs * g[jj][1]; } } }
    }
}

template <class Epi>
__device__ __forceinline__ void run_gemm(LAS unsigned char* lds, const bf16_t* A, const bf16_t* Bt, int M, int N, int K, const Epi& E) {
    int bx_ = (int)blockIdx.x; asm volatile("" : "+s"(bx_));
    pg8::Gemm g{A, Bt, M, N, K}; pg8::StaticOrder S; S.init(M, N, (int)gridDim.x, bx_);
#if USE_FAST_GEMM
    pg8::gemm_phase<Epi, pg8::StaticOrder, GEMM_ALIGN_EPI, true>(lds, g, S, E);
#else
    pg8::gemm_simple<Epi, pg8::StaticOrder>(g, S, E);
#endif
}

__global__ void __launch_bounds__(512, 2) fwd_kernel(Params p) {
    extern __shared__ __attribute__((aligned(16))) unsigned char lds_raw[];
    LAS unsigned char* lds = (LAS unsigned char*)lds_raw;
    cg::grid_group grid = cg::this_grid();
    unsigned char* ws = p.ws;
    const int lo = (int)p.ph_lo, hi = (int)p.ph_hi;
    float* ss = (float*)(ws + WS_SS);
    bf16_t* XA = (bf16_t*)(ws + WS_XA); bf16_t* ACT = (bf16_t*)(ws + WS_ACT);
    bf16_t* Qb = (bf16_t*)(ws + WS_Q); bf16_t* Kb = (bf16_t*)(ws + WS_K); bf16_t* VTb = (bf16_t*)(ws + WS_VT); bf16_t* Ob = (bf16_t*)(ws + WS_O);
    { volatile LAS unsigned* misc = (volatile LAS unsigned*)(lds + 131072); if (threadIdx.x < 32) misc[threadIdx.x] = 0u; }
    __syncthreads();
    XcdBarrier bar = xcd_barrier_post((unsigned*)(ws + WS_CTL), (volatile LAS unsigned*)(lds + 131072 + 32));
    if (p.ph_lo < 0) grid.sync();
    const int G = gridDim.x; const int vcu = (G % 8 == 0) ? ((int)blockIdx.x % 8) * (G / 8) + (int)blockIdx.x / 8 : (int)blockIdx.x;
#define IN(k) (lo <= (k) && (k) < hi)
#define SEAM(k) do { if (IN(k) && IN((k) + 1)) { xcd_barrier(bar); } } while (0)
    for (int rep = 0; rep < REPEAT_PRO; ++rep)
    if (IN(0)) { prologue(p, lds); __syncthreads(); }
    SEAM(0);
    for (int l = 0; l < 2; ++l) {
        const int pb = 1 + 7 * l;
        const bf16_t* Win0 = (const bf16_t*)(ws + WS_WIN) + (size_t)(2 * l) * FF2 * 1024; const bf16_t* Win1 = Win0 + (size_t)FF2 * 1024;
        const bf16_t* Wout0 = (const bf16_t*)(ws + WS_WOUT) + (size_t)(2 * l) * 1024 * FF; const bf16_t* Wout1 = Wout0 + (size_t)1024 * FF;
        const bf16_t* Wqkv = (const bf16_t*)(ws + WS_WQKV) + (size_t)l * 3072 * 1024; const bf16_t* Wo = (const bf16_t*)(ws + WS_WO) + (size_t)l * 1024 * 1024;
        for (int rep = 0; rep < REPEAT_UP; ++rep)
        if (IN(pb + 0)) { pg8::EpiSwiglu E{ACT, ss + (size_t)(3 * l) * MTOK * 16}; run_gemm(lds, XA, Win0, MTOK, FF2, 1024, E); }
        SEAM(pb + 0);
        if (IN(pb + 1)) { pg8::EpiResid<false> E{nullptr, XA, ss + (size_t)(3 * l + 1) * MTOK * 16, 0.5f}; run_gemm(lds, ACT, Wout0, MTOK, 1024, FF, E); }
        SEAM(pb + 1);
        if (IN(pb + 2)) {
            { pg8::EpiQK E{Qb, Kb, ss + (size_t)(3 * l + 1) * MTOK * 16, l == 1 ? (float*)(ws + WS_KMEAN) : nullptr}; run_gemm(lds, XA, Wqkv, MTOK, 2048, 1024, E); }
            { pg8::EpiVT E{VTb, ss + (size_t)(3 * l + 1) * MTOK * 16}; run_gemm(lds, Wqkv + (size_t)2048 * 1024, XA, 1024, MTOK, 1024, E); }
        }
        SEAM(pb + 2);
        for (int rep = 0; rep < REPEAT_ATTN; ++rep)
        if (IN(pb + 3) && !(SKIP_ATTN_MASK & (1 << l))) {
            const float* biasd = (const float*)(ws + WS_BIASD);
            if (l == 0) {
                int lane = threadIdx.x & 63; asm volatile("" : "+v"(lane)); const float* lp = p.d_lam;
                const float s1 = wave_sum(lp[lane] * lp[64 + lane]), s2 = wave_sum(lp[128 + lane] * lp[192 + lane]);
                const float lam = expf(s1) - expf(s2) + 0.2f;
                for (int U = vcu; U < 2048; U += G) { const int c = U & 255, i = U >> 8, bh = c >> 2, s = c & 3, pr = i >> 1; const int qb = (i & 1) ? (8 * pr + 7 - s) : (8 * pr + s);
                    att::diff_unit(bh >> 3, bh & 7, qb, Qb, Kb, VTb, Ob, biasd, lam, p.d_subg, lds); }
            } else {
                for (int U = vcu; U < 2048; U += G) { const int c = U & 255, i = U >> 8, bh = c >> 1, s = c & 1, pr = i >> 1; const int j = (i & 1) ? (4 * pr + 3 - s) : (4 * pr + s);
                    att::moba_unit(bh >> 4, bh & 15, j, Qb, Kb, VTb, Ob, biasd, (const float*)(ws + WS_KMEAN), lds); }
            }
        }
        SEAM(pb + 3);
        if (IN(pb + 4)) { pg8::EpiResid<false> E{nullptr, XA, ss + (size_t)(3 * l + 2) * MTOK * 16, 1.0f}; run_gemm(lds, Ob, Wo, MTOK, 1024, 1024, E); }
        SEAM(pb + 4);
        if (IN(pb + 5)) { pg8::EpiSwiglu E{ACT, ss + (size_t)(3 * l + 2) * MTOK * 16}; run_gemm(lds, XA, Win1, MTOK, FF2, 1024, E); }
        SEAM(pb + 5);
        if (IN(pb + 6)) { pg8::EpiResid<false> E{nullptr, XA, ss + (size_t)(3 * l + 3) * MTOK * 16, 0.5f}; run_gemm(lds, ACT, Wout1, MTOK, 1024, FF, E); }
        SEAM(pb + 6);
    }
    if (IN(15)) final_norm(p);
#undef IN
#undef SEAM
}

extern "C" void kernel_launch(void* const* d_in, const int* in_sizes, int n_in, void* d_out, int out_size, void* d_ws, size_t ws_size, hipStream_t stream) {
    static int grid = 0;
    if (grid == 0) {
        if (n_in != 12 || in_sizes[0] != MTOK * 1024 || out_size != MTOK * 1024 || ws_size < WS_END) { fprintf(stderr, "kernel_launch: unexpected shapes (n_in %d, in0 %d, out %d, ws %zu); nothing launched\n", n_in, n_in > 0 ? in_sizes[0] : -1, out_size, ws_size); grid = -1; return; }
        int dev = 0, cus = 0, per_cu = 0;
        if (hipGetDevice(&dev) != hipSuccess || hipDeviceGetAttribute(&cus, hipDeviceAttributeMultiprocessorCount, dev) != hipSuccess) { grid = -1; return; }
        if (hipFuncSetAttribute((const void*)fwd_kernel, hipFuncAttributeMaxDynamicSharedMemorySize, LDS_BYTES) != hipSuccess) { fprintf(stderr, "kernel_launch: hipFuncSetAttribute failed\n"); grid = -1; return; }
        if (hipOccupancyMaxActiveBlocksPerMultiprocessor(&per_cu, (const void*)fwd_kernel, 512, LDS_BYTES) != hipSuccess || per_cu < 1) { fprintf(stderr, "kernel_launch: occupancy query gives %d\n", per_cu); per_cu = 1; }
        (void)hipGetLastError();
        grid = cus * 1;
    }
    if (grid < 0) return;
    if (hipMemsetAsync((char*)d_ws + WS_CTL, 0, 65536, stream) != hipSuccess) { fprintf(stderr, "kernel_launch: memset of the barrier words failed\n"); return; }
    Params p{};
    p.x = (const float*)d_in[0]; p.rel_bias = (const float*)d_in[1]; p.norm_g = (const float*)d_in[2]; p.final_g = (const float*)d_in[3];
    p.w_in = (const float*)d_in[4]; p.w_out = (const float*)d_in[5]; p.dq_w = (const float*)d_in[6]; p.d_lam = (const float*)d_in[7];
    p.d_subg = (const float*)d_in[8]; p.d_wo = (const float*)d_in[9]; p.mq_w = (const float*)d_in[10]; p.m_wo = (const float*)d_in[11];
    p.out = (float*)d_out; p.ws = (unsigned char*)d_ws;
#if N_LAUNCH_MODE == 1
    p.ph_lo = 0; p.ph_hi = N_PHASES;
    void* args[] = {&p};
    hipError_t e = hipLaunchCooperativeKernel((const void*)fwd_kernel, dim3(grid), dim3(512), args, LDS_BYTES, stream);
    if (e != hipSuccess) fprintf(stderr, "kernel_launch: cooperative launch failed: %s (grid %d)\n", hipGetErrorString(e), grid);
#else
    for (int ph = 0; ph < N_PHASES; ++ph) { p.ph_lo = ph; p.ph_hi = ph + 1; hipLaunchKernelGGL(fwd_kernel, dim3(grid), dim3(512), LDS_BYTES, stream, p); }
#endif
}
```
